# Optimizing an MI355X kernel written in HIP

```python
import math
import jax
import jax.numpy as jnp
from jax import lax
import numpy as np

D_MODEL = 1024
BATCH = 8
SEQ = 2048
DEPTH = 2

MEM_LEN = 256
N_EVEN = (DEPTH + 1) // 2
N_ODD = DEPTH // 2
ALPHA = (2.0 * DEPTH) ** 0.25
BETA = (8.0 * DEPTH) ** -0.25
LN_EPS = 1e-5

GMLP_WIDTH = D_MODEL // 2
GMLP_GROUPS = 4
GMLP_GDIM = GMLP_WIDTH // GMLP_GROUPS
GMLP_CHUNK = 128
HGRN_WIDTH = D_MODEL // 2
HGRN_HEADS = 4
HGRN_DK = HGRN_WIDTH // HGRN_HEADS
HGRN_CHUNK = 64
EVEN_IN_WIDTH = 2 * GMLP_WIDTH + 4 * HGRN_WIDTH

MOBA_HEADS = 16
MOBA_HDIM = D_MODEL // MOBA_HEADS
MOBA_BLOCK = 256
MOBA_TOPK = 3
MOBA_QCHUNK = 16

MEM_HEADS = 4
MEM_HDIM = D_MODEL // MEM_HEADS

D_FF = int(math.ceil(8 * D_MODEL / 3 / 256)) * 256

kernel_name = 'hybrid_gmlp_hgrn2_moba_deepnorm'


def layer_norm(x, g, b):
    xf = x.astype(jnp.float32)
    mu = jnp.mean(xf, axis=-1, keepdims=True)
    var = jnp.mean(jnp.square(xf - mu), axis=-1, keepdims=True)
    return ((xf - mu) * lax.rsqrt(var + LN_EPS)).astype(x.dtype) * g + b


def rms_norm(x, g):
    xf = x.astype(jnp.float32)
    return (xf * lax.rsqrt(jnp.mean(jnp.square(xf), axis=-1, keepdims=True) + LN_EPS)).astype(x.dtype) * g


def alibi_slopes(n_heads):
    return jnp.asarray(2.0 ** (-8.0 * np.arange(1, n_heads + 1) / n_heads), dtype=jnp.float32)


def spatial_gating_unit(u, v, ws, bs, ln_g, ln_b):
    bsz, t_len, _ = u.shape
    v = layer_norm(v.reshape(bsz, t_len, GMLP_GROUPS, GMLP_GDIM),
                   ln_g.reshape(GMLP_GROUPS, GMLP_GDIM), ln_b.reshape(GMLP_GROUPS, GMLP_GDIM))
    v = v.reshape(bsz, t_len // GMLP_CHUNK, GMLP_CHUNK, GMLP_GROUPS, GMLP_GDIM)
    causal = jnp.tril(jnp.ones((GMLP_CHUNK, GMLP_CHUNK), dtype=bool))
    w = jnp.where(causal[None], ws, jnp.zeros_like(ws))
    s = jnp.einsum('gts,bnsgc->bntgc', w, v) + bs.T[:, :, None]
    return u * s.reshape(bsz, t_len, GMLP_WIDTH)


def hgrn2_recurrence(q, f_logit, i, lb):
    bsz, t_len, _ = q.shape
    n_chunks = t_len // HGRN_CHUNK

    def heads(z):
        return z.astype(jnp.float32).reshape(bsz, n_chunks, HGRN_CHUNK, HGRN_HEADS, HGRN_DK).transpose(0, 3, 1, 2, 4)

    f = lb + (1.0 - lb) * jax.nn.sigmoid(f_logit.astype(jnp.float32))
    q_c, k_c, v_c = heads(q), heads(1.0 - f), heads(i)
    cum = jnp.cumsum(heads(jnp.log(f)), axis=3)
    q_dec = q_c * jnp.exp(cum)
    k_dec = k_c * jnp.exp(-cum)
    k_tail = k_c * jnp.exp(cum[..., -1:, :] - cum)
    causal = jnp.tril(jnp.ones((HGRN_CHUNK, HGRN_CHUNK), dtype=bool))
    attn = jnp.where(causal, jnp.einsum('bhntk,bhnsk->bhnts', q_dec, k_dec), 0.0)
    o_intra = jnp.einsum('bhnts,bhnsv->bhntv', attn, v_c)
    chunk_decay = jnp.exp(cum[..., -1, :])
    chunk_update = jnp.einsum('bhnsk,bhnsv->bhnkv', k_tail, v_c)

    def step(state, inp):
        dec, upd = inp
        return dec[..., None] * state + upd, state

    s0 = jnp.zeros((bsz, HGRN_HEADS, HGRN_DK, HGRN_DK), jnp.float32)
    _, s_in = lax.scan(step, s0, (jnp.moveaxis(chunk_decay, 2, 0), jnp.moveaxis(chunk_update, 2, 0)))
    s_in = jnp.moveaxis(s_in, 0, 2)
    o = o_intra + jnp.einsum('bhntk,bhnkv->bhntv', q_dec, s_in)
    return o.transpose(0, 2, 3, 1, 4).reshape(bsz, t_len, HGRN_HEADS, HGRN_DK)


def even_mixer(x, w_in, w_out, a_ws, a_bs, a_ln_g, a_ln_b, b_norm_g, lb):
    bsz, t_len, _ = x.shape
    h = x @ w_in
    cuts = [GMLP_WIDTH, 2 * GMLP_WIDTH, 2 * GMLP_WIDTH + HGRN_WIDTH,
            2 * GMLP_WIDTH + 2 * HGRN_WIDTH, 2 * GMLP_WIDTH + 3 * HGRN_WIDTH]
    a_u, a_v, b_q, b_f, b_i, b_g = jnp.split(h, cuts, axis=-1)
    y_a = spatial_gating_unit(jax.nn.gelu(a_u), jax.nn.gelu(a_v), a_ws, a_bs, a_ln_g, a_ln_b)
    o = hgrn2_recurrence(b_q, b_f, jax.nn.silu(b_i), lb)
    gate = jax.nn.silu(b_g.astype(jnp.float32)).reshape(bsz, t_len, HGRN_HEADS, HGRN_DK)
    y_b = (rms_norm(o, b_norm_g.reshape(HGRN_HEADS, HGRN_DK).astype(jnp.float32)) * gate).astype(x.dtype)
    y = jnp.concatenate([y_a, y_b.reshape(bsz, t_len, HGRN_WIDTH)], axis=-1)
    return y @ w_out


def moba_attention(x, w_qkv, w_out):
    bsz, t_len, _ = x.shape
    n_blocks = -(-t_len // MOBA_BLOCK)
    pad = n_blocks * MOBA_BLOCK - t_len
    top_k = min(MOBA_TOPK, max(n_blocks - 1, 1))
    scale = MOBA_HDIM ** -0.5
    slopes = alibi_slopes(MOBA_HEADS)[None, :, None]
    qkv = (x @ w_qkv).reshape(bsz, t_len, 3, MOBA_HEADS, MOBA_HDIM).transpose(2, 0, 3, 1, 4)
    q, k, v = qkv[0], qkv[1], qkv[2]
    pad_cfg = ((0, 0), (0, 0), (0, pad), (0, 0))
    k_blocks = jnp.pad(k, pad_cfg).reshape(bsz, MOBA_HEADS, n_blocks, MOBA_BLOCK, MOBA_HDIM)
    v_blocks = jnp.pad(v, pad_cfg).reshape(bsz, MOBA_HEADS, n_blocks, MOBA_BLOCK, MOBA_HDIM)
    k_mean = jnp.mean(k_blocks.astype(jnp.float32), axis=3)
    q_block = jnp.arange(t_len) // MOBA_BLOCK
    fully_past = jnp.arange(n_blocks)[None, :] < q_block[:, None]
    affinity = jnp.einsum('bhtd,bhnd->bhtn', q.astype(jnp.float32), k_mean)
    affinity = jnp.where(fully_past, affinity, -jnp.inf)
    _, sel = lax.top_k(affinity, top_k)
    sel_valid = sel < q_block[:, None]
    b_idx = jnp.arange(bsz)[:, None, None, None]
    h_idx = jnp.arange(MOBA_HEADS)[None, :, None, None]
    key_offsets = jnp.arange(MOBA_BLOCK)

    def query_chunk(c):
        t0 = c * MOBA_QCHUNK
        q_c = lax.dynamic_slice_in_dim(q, t0, MOBA_QCHUNK, axis=2)
        sel_c = lax.dynamic_slice_in_dim(sel, t0, MOBA_QCHUNK, axis=2)
        valid_c = lax.dynamic_slice_in_dim(sel_valid, t0, MOBA_QCHUNK, axis=2)
        own = t0 // MOBA_BLOCK
        tq = t0 + jnp.arange(MOBA_QCHUNK)
        k_sel = k_blocks[b_idx, h_idx, sel_c]
        v_sel = v_blocks[b_idx, h_idx, sel_c]
        k_own = lax.dynamic_index_in_dim(k_blocks, own, axis=2, keepdims=False)
        v_own = lax.dynamic_index_in_dim(v_blocks, own, axis=2, keepdims=False)
        dist_sel = (tq[:, None, None] - (sel_c[..., None] * MOBA_BLOCK + key_offsets)).astype(jnp.float32)
        s_sel = (jnp.einsum('bhqd,bhqjsd->bhqjs', q_c, k_sel).astype(jnp.float32) * scale
                 - slopes[..., None, None] * dist_sel)
        s_sel = jnp.where(valid_c[..., None], s_sel, -jnp.inf).reshape(bsz, MOBA_HEADS, MOBA_QCHUNK, top_k * MOBA_BLOCK)
        dist_own = (tq[:, None] - (own * MOBA_BLOCK + key_offsets)[None, :]).astype(jnp.float32)
        s_own = (jnp.einsum('bhqd,bhsd->bhqs', q_c, k_own).astype(jnp.float32) * scale
                 - slopes[..., None] * dist_own)
        s_own = jnp.where(dist_own >= 0, s_own, -jnp.inf)
        p = jax.nn.softmax(jnp.concatenate([s_sel, s_own], axis=-1), axis=-1).astype(v.dtype)
        p_sel = p[..., :top_k * MOBA_BLOCK].reshape(bsz, MOBA_HEADS, MOBA_QCHUNK, top_k, MOBA_BLOCK)
        p_own = p[..., top_k * MOBA_BLOCK:]
        return (jnp.einsum('bhqjs,bhqjsd->bhqd', p_sel, v_sel)
                + jnp.einsum('bhqs,bhsd->bhqd', p_own, v_own))

    out = lax.map(query_chunk, jnp.arange(t_len // MOBA_QCHUNK))
    out = out.transpose(1, 0, 3, 2, 4).reshape(bsz, t_len, D_MODEL)
    return out @ w_out


def memory_cross_attention(x, mem, w_q, w_kv, w_o):
    bsz, t_len, _ = x.shape
    q = (x @ w_q).reshape(bsz, t_len, MEM_HEADS, MEM_HDIM)
    kv = (mem @ w_kv).reshape(bsz, mem.shape[1], 2, MEM_HEADS, MEM_HDIM)
    s = jnp.einsum('bthd,bmhd->bhtm', q, kv[:, :, 0]).astype(jnp.float32) * (MEM_HDIM ** -0.5)
    p = jax.nn.softmax(s, axis=-1).astype(x.dtype)
    o = jnp.einsum('bhtm,bmhd->bthd', p, kv[:, :, 1]).reshape(bsz, t_len, D_MODEL)
    return o @ w_o


def swiglu_ffn(x, w_in, w_out):
    gate, up = jnp.split(x @ w_in, 2, axis=-1)
    return (jax.nn.silu(gate) * up) @ w_out


def setup_inputs(seed: int = 0) -> dict:
    key = jax.random.key(seed)
    ks = jax.random.split(key, 24)

    def nrm(k, shape, std):
        return jax.random.normal(k, shape, jnp.float32) * std

    d_inv = D_MODEL ** -0.5
    mix_w = GMLP_WIDTH + HGRN_WIDTH
    return {
        'x': nrm(ks[0], (BATCH, SEQ, D_MODEL), 1.0),
        'mem': nrm(ks[1], (BATCH, MEM_LEN, D_MODEL), 1.0),
        'ln_g': 1.0 + nrm(ks[2], (DEPTH, 3, D_MODEL), 0.02),
        'ln_b': nrm(ks[3], (DEPTH, 3, D_MODEL), 0.02),
        'x_wq': nrm(ks[4], (DEPTH, D_MODEL, D_MODEL), d_inv),
        'x_wkv': jnp.concatenate([nrm(ks[5], (DEPTH, D_MODEL, D_MODEL), d_inv),
                                  nrm(ks[6], (DEPTH, D_MODEL, D_MODEL), d_inv * BETA)], axis=-1),
        'x_wo': nrm(ks[7], (DEPTH, D_MODEL, D_MODEL), d_inv * BETA),
        'ffn_w_in': nrm(ks[8], (DEPTH, D_MODEL, 2 * D_FF), d_inv),
        'ffn_w_out': nrm(ks[9], (DEPTH, D_FF, D_MODEL), D_FF ** -0.5 * BETA),
        'ev_w_in': nrm(ks[10], (N_EVEN, D_MODEL, EVEN_IN_WIDTH), d_inv),
        'ev_w_out': nrm(ks[11], (N_EVEN, mix_w, D_MODEL), mix_w ** -0.5 * BETA),
        'a_ws': nrm(ks[12], (N_EVEN, GMLP_GROUPS, GMLP_CHUNK, GMLP_CHUNK), GMLP_CHUNK ** -0.5),
        'a_bs': 1.0 + nrm(ks[13], (N_EVEN, GMLP_GROUPS, GMLP_CHUNK), 0.1),
        'a_ln_g': 1.0 + nrm(ks[14], (N_EVEN, GMLP_WIDTH), 0.02),
        'a_ln_b': nrm(ks[15], (N_EVEN, GMLP_WIDTH), 0.02),
        'b_norm_g': 1.0 + nrm(ks[16], (N_EVEN, HGRN_WIDTH), 0.02),
        'hgrn_lb_logits': nrm(ks[17], (N_EVEN + 1, HGRN_WIDTH), 0.1),
        'od_w_qkv': jnp.concatenate([nrm(ks[18], (N_ODD, D_MODEL, 2 * D_MODEL), d_inv),
                                     nrm(ks[19], (N_ODD, D_MODEL, D_MODEL), d_inv * BETA)], axis=-1),
        'od_w_out': nrm(ks[20], (N_ODD, D_MODEL, D_MODEL), d_inv * BETA),
    }


def reference(x, mem, ln_g, ln_b, x_wq, x_wkv, x_wo, ffn_w_in, ffn_w_out, ev_w_in, ev_w_out,
              a_ws, a_bs, a_ln_g, a_ln_b, b_norm_g, hgrn_lb_logits, od_w_qkv, od_w_out):
    lb_all = jnp.cumsum(jax.nn.softmax(hgrn_lb_logits.astype(jnp.float32), axis=0), axis=0)
    for l in range(DEPTH):
        j = l // 2
        if l % 2 == 0:
            y = even_mixer(x, ev_w_in[j], ev_w_out[j], a_ws[j], a_bs[j], a_ln_g[j], a_ln_b[j],
                           b_norm_g[j], lb_all[j])
        else:
            y = moba_attention(x, od_w_qkv[j], od_w_out[j])
        x = layer_norm(ALPHA * x + y, ln_g[l, 0], ln_b[l, 0])
        x = layer_norm(ALPHA * x + memory_cross_attention(x, mem, x_wq[l], x_wkv[l], x_wo[l]),
                       ln_g[l, 1], ln_b[l, 1])
        x = layer_norm(ALPHA * x + swiglu_ffn(x, ffn_w_in[l], ffn_w_out[l]), ln_g[l, 2], ln_b[l, 2])
    return x
```

```cpp
#include <hip/hip_runtime.h>
#include <hip/hip_cooperative_groups.h>
#include <cstdio>
#include <cstdint>
namespace cg = cooperative_groups;

#ifndef MULTI_LAUNCH
#define MULTI_LAUNCH 0
#endif

#ifndef PHMASK
#define PHMASK 0xFFFFFFFFu
#endif
#define EN(x) ((PHMASK >> (x)) & 1u)
#define DI __device__ __forceinline__
typedef unsigned short u16;
typedef short bf16x8 __attribute__((ext_vector_type(8)));
typedef float f32x4 __attribute__((ext_vector_type(4)));
typedef unsigned u32x4 __attribute__((ext_vector_type(4)));
typedef unsigned u32x2 __attribute__((ext_vector_type(2)));

constexpr int NT = 16384, DM = 1024, SEQ = 2048;
constexpr int DFF = 2816;
constexpr float ALPHA = 1.41421356237309515f;
constexpr float LN_EPS = 1e-5f;
constexpr int LDS_BYTES = 73728;
constexpr int NPHASE = 24;

constexpr size_t MB = 1u << 20;
constexpr size_t O_WT_EVIN = 0;
constexpr size_t O_WT_EVOUT = O_WT_EVIN + 6 * MB;
constexpr size_t O_WT_WQ = O_WT_EVOUT + 2 * MB;
constexpr size_t O_WT_WKV = O_WT_WQ + 4 * MB;
constexpr size_t O_WT_WO = O_WT_WKV + 8 * MB;
constexpr size_t O_WT_FIN = O_WT_WO + 4 * MB;
constexpr size_t O_WT_FOUT = O_WT_FIN + 22 * MB;
constexpr size_t O_WT_QKV = O_WT_FOUT + 11 * MB;
constexpr size_t O_WT_ODOUT = O_WT_QKV + 6 * MB;
constexpr size_t O_XB = O_WT_ODOUT + 2 * MB;
constexpr size_t O_H = O_XB + 32 * MB;
constexpr size_t O_YM = O_H + 96 * MB;
constexpr size_t O_MEMB = O_YM + 32 * MB;
constexpr size_t O_KVK = O_MEMB + 4 * MB;
constexpr size_t O_KVV = O_KVK + 8 * MB;
constexpr size_t O_KM = O_KVV + 8 * MB;
constexpr size_t WS_END = O_KM + MB;

struct Params { const float* in[19]; float* out; char* ws; int ph0, ph1; };

DI int get_tid() { int t = threadIdx.x; asm volatile("" : "+v"(t)); return t; }
DI u16 f2bf(float x) { unsigned u = __float_as_uint(x); u += 0x7fffu + ((u >> 16) & 1u); return (u16)(u >> 16); }
DI float bf2f(u16 h) { return __uint_as_float(((unsigned)h) << 16); }
DI unsigned pack2(float a, float b) { return (unsigned)f2bf(a) | ((unsigned)f2bf(b) << 16); }
DI f32x4 mfma16(bf16x8 a, bf16x8 b, f32x4 c) { return __builtin_amdgcn_mfma_f32_16x16x32_bf16(a, b, c, 0, 0, 0); }
DI bf16x8 mk8(u32x2 lo, u32x2 hi) { u32x4 t; t.x = lo.x; t.y = lo.y; t.z = hi.x; t.w = hi.y; return __builtin_bit_cast(bf16x8, t); }
DI bf16x8 pack8(f32x4 a, f32x4 b) { u32x4 t; t.x = pack2(a[0], a[1]); t.y = pack2(a[2], a[3]); t.z = pack2(b[0], b[1]); t.w = pack2(b[2], b[3]); return __builtin_bit_cast(bf16x8, t); }
DI float gelu_tanh(float x) { float y = 0.7978845608028654f * (x + 0.044715f * x * x * x); float t = 1.f - 2.f / (1.f + __expf(2.f * y)); return 0.5f * x * (1.f + t); }
DI float sigmoidf(float x) { return 1.f / (1.f + __expf(-x)); }
DI float siluf(float x) { return x / (1.f + __expf(-x)); }

constexpr int LDT = 72;
DI void tile_map(int t, int nN, int GM, int& pm, int& pn) {
    const int x = t & 7, idx = t >> 3;
    const int per_group = GM * nN, g = idx / per_group, r = idx % per_group;
    pm = x + 8 * (g * GM + (r % GM)); pn = r / GM;
}

template <class Epi>
DI void gemm_tile(const u16* __restrict__ A, int lda, const u16* __restrict__ Bt, int ldb, int K, int row0, int col0, char* lds, const Epi& epi) {
    const int tid = get_tid(), lane = tid & 63, w = tid >> 6, wr = w >> 1, wc = w & 1, fr = lane & 15, fq = lane >> 4;
    u16* sA = (u16*)lds;
    u16* sB = sA + 2 * 128 * LDT;
    const int lr = tid >> 3, lc = (tid & 7) * 8;
    const u16* gA = A + (size_t)(row0 + lr) * lda + lc;
    const u16* gB = Bt + (size_t)(col0 + lr) * ldb + lc;
    u32x4 ra[4], rb[4];
    f32x4 acc[4][4];
#pragma unroll
    for (int i = 0; i < 4; ++i)
#pragma unroll
        for (int j = 0; j < 4; ++j) acc[i][j] = (f32x4){0.f, 0.f, 0.f, 0.f};
    const int nk = K >> 6;
#pragma unroll
    for (int i = 0; i < 4; ++i) { ra[i] = *(const u32x4*)(gA + (size_t)i * 32 * lda); rb[i] = *(const u32x4*)(gB + (size_t)i * 32 * ldb); }
#pragma unroll
    for (int i = 0; i < 4; ++i) { *(u32x4*)(sA + (lr + i * 32) * LDT + lc) = ra[i]; *(u32x4*)(sB + (lr + i * 32) * LDT + lc) = rb[i]; }
    __syncthreads();
    for (int kt = 0; kt < nk; ++kt) {
        const int st = kt & 1;
        if (kt + 1 < nk) {
#pragma unroll
            for (int i = 0; i < 4; ++i) { ra[i] = *(const u32x4*)(gA + (size_t)i * 32 * lda + (kt + 1) * 64); rb[i] = *(const u32x4*)(gB + (size_t)i * 32 * ldb + (kt + 1) * 64); }
        }
        const u16* cA = sA + st * 128 * LDT + (wr * 64 + fr) * LDT + fq * 8;
        const u16* cB = sB + st * 128 * LDT + (wc * 64 + fr) * LDT + fq * 8;
#pragma unroll
        for (int ks = 0; ks < 2; ++ks) {
            bf16x8 a[4], b[4];
#pragma unroll
            for (int i = 0; i < 4; ++i) { a[i] = *(const bf16x8*)(cA + i * 16 * LDT + ks * 32); b[i] = *(const bf16x8*)(cB + i * 16 * LDT + ks * 32); }
#pragma unroll
            for (int i = 0; i < 4; ++i)
#pragma unroll
                for (int j = 0; j < 4; ++j) acc[i][j] = mfma16(a[i], b[j], acc[i][j]);
        }
        if (kt + 1 < nk) {
            const int s2 = st ^ 1;
#pragma unroll
            for (int i = 0; i < 4; ++i) { *(u32x4*)(sA + s2 * 128 * LDT + (lr + i * 32) * LDT + lc) = ra[i]; *(u32x4*)(sB + s2 * 128 * LDT + (lr + i * 32) * LDT + lc) = rb[i]; }
        }
        __syncthreads();
    }
    epi(acc, row0 + wr * 64, col0 + wc * 64, fr, fq);
}

#define EPI_LOOP _Pragma("unroll") for (int mi = 0; mi < 4; ++mi) _Pragma("unroll") for (int ni = 0; ni < 4; ++ni) _Pragma("unroll") for (int i = 0; i < 4; ++i)

struct EpiH0 {
    u16* H; const float* lbl;
    DI void operator()(const f32x4 (&acc)[4][4], int rb, int cb, int fr, int fq) const {
        const int region = cb >> 9;
        EPI_LOOP {
            const int row = rb + mi * 16 + fq * 4 + i, col = cb + ni * 16 + fr;
            float v = acc[mi][ni][i];
            if (region <= 1) v = gelu_tanh(v);
            else if (region == 3) { const int c = col - 1536; const float lb = 1.f / (1.f + __expf(lbl[512 + c] - lbl[c])); v = __logf(lb + (1.f - lb) * sigmoidf(v)); }
            else if (region >= 4) v = siluf(v);
            H[(size_t)row * 3072 + col] = f2bf(v);
        }
    }
};
struct EpiKV {
    u16* Kd; u16* Vt;
    DI void operator()(const f32x4 (&acc)[4][4], int rb, int cb, int fr, int fq) const {
        if (cb < 1024) {
            EPI_LOOP { const int row = rb + mi * 16 + fq * 4 + i, col = cb + ni * 16 + fr; Kd[(size_t)row * 1024 + col] = f2bf(acc[mi][ni][i]); }
        } else {
#pragma unroll
            for (int mi = 0; mi < 4; ++mi)
#pragma unroll
                for (int ni = 0; ni < 4; ++ni) {
                    const int row = rb + mi * 16 + fq * 4, c = cb - 1024 + ni * 16 + fr, b = row >> 8, m = row & 255, h = c >> 8, d = c & 255;
                    u32x2 o; o.x = pack2(acc[mi][ni][0], acc[mi][ni][1]); o.y = pack2(acc[mi][ni][2], acc[mi][ni][3]);
                    *(u32x2*)(Vt + ((size_t)((b * 4 + h) * 256 + d)) * 256 + m) = o;
                }
        }
    }
};
struct EpiZ {
    const float* res; float* out;
    DI void operator()(const f32x4 (&acc)[4][4], int rb, int cb, int fr, int fq) const {
        EPI_LOOP { const size_t o = (size_t)(rb + mi * 16 + fq * 4 + i) * 1024 + cb + ni * 16 + fr; out[o] = ALPHA * res[o] + acc[mi][ni][i]; }
    }
};
struct EpiBf {
    u16* D; int ld; float scale;
    DI void operator()(const f32x4 (&acc)[4][4], int rb, int cb, int fr, int fq) const {
        EPI_LOOP { D[(size_t)(rb + mi * 16 + fq * 4 + i) * ld + cb + ni * 16 + fr] = f2bf(acc[mi][ni][i] * scale); }
    }
};
struct EpiFFN {
    u16* Hd;
    DI void operator()(const f32x4 (&acc)[4][4], int rb, int cb, int fr, int fq) const {
        const int grp = cb >> 6;
#pragma unroll
        for (int mi = 0; mi < 4; ++mi)
#pragma unroll
            for (int ni = 0; ni < 2; ++ni)
#pragma unroll
                for (int i = 0; i < 4; ++i) {
                    const float g = acc[mi][ni][i], u = acc[mi][ni + 2][i];
                    Hd[(size_t)(rb + mi * 16 + fq * 4 + i) * DFF + grp * 32 + ni * 16 + fr] = f2bf(siluf(g) * u);
                }
    }
};
struct EpiQKV1 {
    u16* Q; u16* Kd; u16* Vt;
    DI void operator()(const f32x4 (&acc)[4][4], int rb, int cb, int fr, int fq) const {
        if (cb < 1024) {
            EPI_LOOP { Q[(size_t)(rb + mi * 16 + fq * 4 + i) * 1024 + cb + ni * 16 + fr] = f2bf(acc[mi][ni][i] * 0.125f); }
        } else if (cb < 2048) {
            EPI_LOOP { Kd[(size_t)(rb + mi * 16 + fq * 4 + i) * 1024 + cb - 1024 + ni * 16 + fr] = f2bf(acc[mi][ni][i]); }
        } else {
#pragma unroll
            for (int mi = 0; mi < 4; ++mi)
#pragma unroll
                for (int ni = 0; ni < 4; ++ni) {
                    const int row = rb + mi * 16 + fq * 4, c = cb - 2048 + ni * 16 + fr, b = row >> 11, t = row & 2047, h = c >> 6, d = c & 63;
                    u32x2 o; o.x = pack2(acc[mi][ni][0], acc[mi][ni][1]); o.y = pack2(acc[mi][ni][2], acc[mi][ni][3]);
                    *(u32x2*)(Vt + ((size_t)((b * 16 + h) * 64 + d)) * 2048 + t) = o;
                }
        }
    }
};

template <class Epi>
DI void gemm_phase(const u16* A, int lda, const u16* Bt, int ldb, int K, int nM, int nN, int GM, char* lds, const Epi& epi, int t_begin, int t_total_before) {
    (void)t_begin;
    const int ntile = nM * nN;
    for (int t = blockIdx.x; t < t_total_before + ntile; t += gridDim.x) {
        if (t < t_total_before) continue;
        int pm, pn; tile_map(t - t_total_before, nN, GM, pm, pn);
        gemm_tile(A, lda, Bt, ldb, K, pm * 128, pn * 128, lds, epi);
    }
}

DI void transpose_item(const float* __restrict__ W, int K, int N, u16* __restrict__ WT, int perm, int item, float* scr) {
    const int ntn = N >> 6, kb = item / ntn, nb = item % ntn, k0 = kb * 64, n0 = nb * 64, tid = get_tid();
    __syncthreads();
#pragma unroll
    for (int i = 0; i < 16; ++i) { const int kk = i * 4 + (tid >> 6), nn = tid & 63; scr[kk * 65 + nn] = W[(size_t)(k0 + kk) * N + n0 + nn]; }
    __syncthreads();
    const int n = tid >> 2, c = tid & 3;
    const float* s = scr + (c * 16) * 65 + n;
    u32x4 o0, o1;
    o0.x = pack2(s[0 * 65], s[1 * 65]); o0.y = pack2(s[2 * 65], s[3 * 65]); o0.z = pack2(s[4 * 65], s[5 * 65]); o0.w = pack2(s[6 * 65], s[7 * 65]);
    o1.x = pack2(s[8 * 65], s[9 * 65]); o1.y = pack2(s[10 * 65], s[11 * 65]); o1.z = pack2(s[12 * 65], s[13 * 65]); o1.w = pack2(s[14 * 65], s[15 * 65]);
    int nsrc = n0 + n, drow = nsrc;
    if (perm) { if (nsrc < DFF) drow = (nsrc >> 5) * 64 + (nsrc & 31); else { const int n2 = nsrc - DFF; drow = (n2 >> 5) * 64 + 32 + (n2 & 31); } }
    u32x4* dst = (u32x4*)(WT + (size_t)drow * K + k0 + c * 16);
    dst[0] = o0; dst[1] = o1;
}

DI void phase_prep(const Params& p, char* lds) {
    float* scr = (float*)lds;
    char* ws = p.ws;
    constexpr int T1 = 16 * 48, TS = 16 * 16, TKV = 16 * 32, TFI = 16 * 88, TFO = 44 * 16;
    constexpr int NTR = T1 + TS + 2 * TS + 2 * TKV + 2 * TS + 2 * TFI + 2 * TFO + T1 + TS;
    constexpr int NXC = NT * DM / 2048, NMC = 2048 * DM / 2048;
    for (int it = blockIdx.x; it < NTR + NXC + NMC; it += gridDim.x) {
        int r = it;
        if (r < NTR) {
            if (r < T1) { transpose_item(p.in[9], 1024, 3072, (u16*)(ws + O_WT_EVIN), 0, r, scr); continue; } r -= T1;
            if (r < TS) { transpose_item(p.in[10], 1024, 1024, (u16*)(ws + O_WT_EVOUT), 0, r, scr); continue; } r -= TS;
            if (r < 2 * TS) { const int l = r / TS; transpose_item(p.in[4] + (size_t)l * 1024 * 1024, 1024, 1024, (u16*)(ws + O_WT_WQ + l * 2 * MB), 0, r % TS, scr); continue; } r -= 2 * TS;
            if (r < 2 * TKV) { const int l = r / TKV; transpose_item(p.in[5] + (size_t)l * 1024 * 2048, 1024, 2048, (u16*)(ws + O_WT_WKV + l * 4 * MB), 0, r % TKV, scr); continue; } r -= 2 * TKV;
            if (r < 2 * TS) { const int l = r / TS; transpose_item(p.in[6] + (size_t)l * 1024 * 1024, 1024, 1024, (u16*)(ws + O_WT_WO + l * 2 * MB), 0, r % TS, scr); continue; } r -= 2 * TS;
            if (r < 2 * TFI) { const int l = r / TFI; transpose_item(p.in[7] + (size_t)l * 1024 * 5632, 1024, 5632, (u16*)(ws + O_WT_FIN + l * 11 * MB), 1, r % TFI, scr); continue; } r -= 2 * TFI;
            if (r < 2 * TFO) { const int l = r / TFO; transpose_item(p.in[8] + (size_t)l * 2816 * 1024, 2816, 1024, (u16*)(ws + O_WT_FOUT + l * (11 * MB / 2)), 0, r % TFO, scr); continue; } r -= 2 * TFO;
            if (r < T1) { transpose_item(p.in[17], 1024, 3072, (u16*)(ws + O_WT_QKV), 0, r, scr); continue; } r -= T1;
            transpose_item(p.in[18], 1024, 1024, (u16*)(ws + O_WT_ODOUT), 0, r, scr);
            continue;
        }
        r -= NTR;
        const float* src; u16* dst;
        if (r < NXC) { src = p.in[0]; dst = (u16*)(ws + O_XB); } else { r -= NXC; src = p.in[1]; dst = (u16*)(ws + O_MEMB); }
        const size_t e = (size_t)r * 2048 + get_tid() * 8;
        const f32x4 a = *(const f32x4*)(src + e), b = *(const f32x4*)(src + e + 4);
        u32x4 o; o.x = pack2(a[0], a[1]); o.y = pack2(a[2], a[3]); o.z = pack2(b[0], b[1]); o.w = pack2(b[2], b[3]);
        *(u32x4*)(dst + e) = o;
    }
}

DI void phase_ln(const float* __restrict__ g, const float* __restrict__ bta, float* xio, u16* xb) {
    const int tid = get_tid(), lane = tid & 63, gw = blockIdx.x * 4 + (tid >> 6), nw = gridDim.x * 4;
    for (int row = gw; row < NT; row += nw) {
        f32x4* xr = (f32x4*)(xio + (size_t)row * 1024);
        f32x4 v[4]; float s = 0.f;
#pragma unroll
        for (int j = 0; j < 4; ++j) { v[j] = xr[lane + 64 * j]; s += (v[j][0] + v[j][1]) + (v[j][2] + v[j][3]); }
#pragma unroll
        for (int o = 1; o < 64; o <<= 1) s += __shfl_xor(s, o);
        const float mean = s * (1.f / 1024.f); float q = 0.f;
#pragma unroll
        for (int j = 0; j < 4; ++j) { v[j] = v[j] - mean; q += (v[j][0] * v[j][0] + v[j][1] * v[j][1]) + (v[j][2] * v[j][2] + v[j][3] * v[j][3]); }
#pragma unroll
        for (int o = 1; o < 64; o <<= 1) q += __shfl_xor(q, o);
        const float rstd = rsqrtf(q * (1.f / 1024.f) + LN_EPS);
#pragma unroll
        for (int j = 0; j < 4; ++j) {
            const f32x4 gg = ((const f32x4*)g)[lane + 64 * j], bb = ((const f32x4*)bta)[lane + 64 * j];
            const f32x4 y = v[j] * rstd * gg + bb;
            xr[lane + 64 * j] = y;
            u32x2 o; o.x = pack2(y[0], y[1]); o.y = pack2(y[2], y[3]);
            ((u32x2*)(xb + (size_t)row * 1024))[lane + 64 * j] = o;
        }
    }
}

DI void gmlp_item(const Params& p, int item, char* lds) {
    const int tid = get_tid(), lane = tid & 63, w = tid >> 6, wr = w >> 1, wc = w & 1, fr = lane & 15, fq = lane >> 4;
    const int g = item & 3, n = (item >> 2) & 15, b = item >> 6;
    const u16* H = (const u16*)(p.ws + O_H);
    u16* YM = (u16*)(p.ws + O_YM);
    u16* sW = (u16*)lds; u16* sV = sW + 128 * 136;
    const size_t row_base = (size_t)b * SEQ + n * 128;
    __syncthreads();
    {
        const float* Wg = p.in[11] + (size_t)g * 128 * 128;
#pragma unroll 4
        for (int c = tid; c < 128 * 32; c += 256) {
            const int t = c >> 5, s4 = (c & 31) * 4;
            const f32x4 v = *(const f32x4*)(Wg + t * 128 + s4);
            u32x2 o; o.x = pack2(s4 + 0 <= t ? v[0] : 0.f, s4 + 1 <= t ? v[1] : 0.f); o.y = pack2(s4 + 2 <= t ? v[2] : 0.f, s4 + 3 <= t ? v[3] : 0.f);
            *(u32x2*)(sW + t * 136 + s4) = o;
        }
    }
    {
        const int r = tid >> 1, half = tid & 1;
        const u16* src = H + (row_base + r) * 3072 + 512 + g * 128 + half * 64;
        float x[64]; float s = 0.f;
#pragma unroll
        for (int j = 0; j < 8; ++j) {
            const u32x4 q = *(const u32x4*)(src + j * 8);
#pragma unroll
            for (int e = 0; e < 4; ++e) { x[j * 8 + 2 * e] = __uint_as_float(q[e] << 16); x[j * 8 + 2 * e + 1] = __uint_as_float(q[e] & 0xffff0000u); }
        }
#pragma unroll
        for (int j = 0; j < 64; ++j) s += x[j];
        s += __shfl_xor(s, 1);
        const float mean = s * (1.f / 128.f); float q2 = 0.f;
#pragma unroll
        for (int j = 0; j < 64; ++j) { x[j] -= mean; q2 += x[j] * x[j]; }
        q2 += __shfl_xor(q2, 1);
        const float rstd = rsqrtf(q2 * (1.f / 128.f) + LN_EPS);
        const float* lg = p.in[13] + g * 128 + half * 64; const float* lb = p.in[14] + g * 128 + half * 64;
#pragma unroll
        for (int j = 0; j < 64; ++j) sV[(half * 64 + j) * 136 + r] = f2bf(x[j] * rstd * lg[j] + lb[j]);
    }
    __syncthreads();
    f32x4 acc[4][4];
#pragma unroll
    for (int i = 0; i < 4; ++i)
#pragma unroll
        for (int j = 0; j < 4; ++j) acc[i][j] = (f32x4){0.f, 0.f, 0.f, 0.f};
    const u16* cA = sW + (wr * 64 + fr) * 136 + fq * 8;
    const u16* cB = sV + (wc * 64 + fr) * 136 + fq * 8;
#pragma unroll
    for (int ks = 0; ks < 4; ++ks) {
        bf16x8 a[4], bb[4];
#pragma unroll
        for (int i = 0; i < 4; ++i) { a[i] = *(const bf16x8*)(cA + i * 16 * 136 + ks * 32); bb[i] = *(const bf16x8*)(cB + i * 16 * 136 + ks * 32); }
#pragma unroll
        for (int i = 0; i < 4; ++i)
#pragma unroll
            for (int j = 0; j < 4; ++j) acc[i][j] = mfma16(a[i], bb[j], acc[i][j]);
    }
    const float* bs = p.in[12] + g * 128;
#pragma unroll
    for (int mi = 0; mi < 4; ++mi)
#pragma unroll
        for (int i = 0; i < 4; ++i) {
            const int t = wr * 64 + mi * 16 + fq * 4 + i; const float bt = bs[t];
#pragma unroll
            for (int ni = 0; ni < 4; ++ni) {
                const int c = wc * 64 + ni * 16 + fr;
                const float u = bf2f(H[(row_base + t) * 3072 + g * 128 + c]);
                YM[(row_base + t) * 1024 + g * 128 + c] = f2bf(u * (acc[mi][ni][i] + bt));
            }
        }
}

DI void hgrn_item(const Params& p, int item, char* lds) {
    const int tid = get_tid(), lane = tid & 63, w = tid >> 6, fr = lane & 15, fq = lane >> 4;
    const int h = item & 3, b = item >> 2;
    const u16* H = (const u16*)(p.ws + O_H);
    u16* YM = (u16*)(p.ws + O_YM);
    u16* sQ = (u16*)lds;
    u16* sKd = sQ + 64 * 136;
    u16* sKt = sKd + 64 * 136;
    u16* sI = sKt + 128 * 72;
    float* sDec = (float*)(sI + 128 * 72);
    float* sTot = sDec + 128;
    u16* sAt = sKd;
    float* sSsq = (float*)(sKd + 64 * 72);
    const float* gn = p.in[15] + h * 128;
    f32x4 st[8][2];
#pragma unroll
    for (int i = 0; i < 8; ++i) { st[i][0] = (f32x4){0.f, 0.f, 0.f, 0.f}; st[i][1] = (f32x4){0.f, 0.f, 0.f, 0.f}; }
    const int ch = tid & 127, th = tid >> 7;
    for (int n = 0; n < 32; ++n) {
        const size_t row_base = (size_t)b * SEQ + n * 64;
        __syncthreads();
        {
            const u16* src = H + (row_base + th * 32) * 3072 + h * 128 + ch;
            float cum[32];
            float run = 0.f;
#pragma unroll
            for (int j = 0; j < 32; ++j) { run += bf2f(src[(size_t)j * 3072 + 1536]); cum[j] = run; }
            sTot[th * 128 + ch] = run;
            __syncthreads();
            const float t0 = sTot[ch], t1 = sTot[128 + ch], total = t0 + t1, off = th ? t0 : 0.f;
            if (th == 0) sDec[ch] = __expf(total);
            unsigned kt[16], iv[16];
            float prev = off;
#pragma unroll
            for (int j = 0; j < 32; ++j) {
                const float c = cum[j] + off;
                const float lf = c - prev; prev = c;
                const float q = bf2f(src[(size_t)j * 3072 + 1024]);
                const float iv_ = bf2f(src[(size_t)j * 3072 + 2048]);
                const float kc = 1.f - __expf(lf);
                sQ[(th * 32 + j) * 136 + ch] = f2bf(q * __expf(c));
                sKd[(th * 32 + j) * 136 + ch] = f2bf(kc * __expf(-c));
                const unsigned ktv = f2bf(kc * __expf(total - c)), ivv = f2bf(iv_);
                if (j & 1) { kt[j >> 1] |= ktv << 16; iv[j >> 1] |= ivv << 16; } else { kt[j >> 1] = ktv; iv[j >> 1] = ivv; }
            }
#pragma unroll
            for (int j = 0; j < 4; ++j) {
                *(u32x4*)(sKt + ch * 72 + th * 32 + j * 8) = (u32x4){kt[4 * j], kt[4 * j + 1], kt[4 * j + 2], kt[4 * j + 3]};
                *(u32x4*)(sI + ch * 72 + th * 32 + j * 8) = (u32x4){iv[4 * j], iv[4 * j + 1], iv[4 * j + 2], iv[4 * j + 3]};
            }
        }
        __syncthreads();
        f32x4 at[4];
#pragma unroll
        for (int nt = 0; nt < 4; ++nt) at[nt] = (f32x4){0.f, 0.f, 0.f, 0.f};
#pragma unroll
        for (int ks = 0; ks < 4; ++ks) {
            const bf16x8 a = *(const bf16x8*)(sQ + (16 * w + fr) * 136 + ks * 32 + fq * 8);
#pragma unroll
            for (int nt = 0; nt < 4; ++nt) { const bf16x8 bb = *(const bf16x8*)(sKd + (nt * 16 + fr) * 136 + ks * 32 + fq * 8); at[nt] = mfma16(a, bb, at[nt]); }
        }
        __syncthreads();
#pragma unroll
        for (int nt = 0; nt < 4; ++nt)
#pragma unroll
            for (int i = 0; i < 4; ++i) { const int t = 16 * w + fq * 4 + i, s = nt * 16 + fr; sAt[t * 72 + s] = f2bf(s <= t ? at[nt][i] : 0.f); }
        __syncthreads();
        f32x4 oacc[4][2];
#pragma unroll
        for (int mt = 0; mt < 4; ++mt) { oacc[mt][0] = (f32x4){0.f, 0.f, 0.f, 0.f}; oacc[mt][1] = (f32x4){0.f, 0.f, 0.f, 0.f}; }
#pragma unroll
        for (int ks = 0; ks < 2; ++ks) {
            bf16x8 bb[2];
#pragma unroll
            for (int nt = 0; nt < 2; ++nt) bb[nt] = *(const bf16x8*)(sI + (32 * w + nt * 16 + fr) * 72 + ks * 32 + fq * 8);
#pragma unroll
            for (int mt = 0; mt < 4; ++mt) {
                const bf16x8 a = *(const bf16x8*)(sAt + (mt * 16 + fr) * 72 + ks * 32 + fq * 8);
                oacc[mt][0] = mfma16(a, bb[0], oacc[mt][0]); oacc[mt][1] = mfma16(a, bb[1], oacc[mt][1]);
            }
        }
#pragma unroll
        for (int s = 0; s < 4; ++s) {
            const bf16x8 b0 = pack8(st[2 * s][0], st[2 * s + 1][0]), b1 = pack8(st[2 * s][1], st[2 * s + 1][1]);
#pragma unroll
            for (int mt = 0; mt < 4; ++mt) {
                const u16* qa = sQ + (mt * 16 + fr) * 136 + 32 * s + fq * 4;
                const bf16x8 a = mk8(*(const u32x2*)qa, *(const u32x2*)(qa + 16));
                oacc[mt][0] = mfma16(a, b0, oacc[mt][0]); oacc[mt][1] = mfma16(a, b1, oacc[mt][1]);
            }
        }
#pragma unroll
        for (int kt = 0; kt < 8; ++kt) {
            const f32x4 d = *(const f32x4*)(sDec + kt * 16 + fq * 4);
            st[kt][0] = st[kt][0] * d; st[kt][1] = st[kt][1] * d;
        }
#pragma unroll
        for (int ks = 0; ks < 2; ++ks) {
            bf16x8 bb[2];
#pragma unroll
            for (int nt = 0; nt < 2; ++nt) bb[nt] = *(const bf16x8*)(sI + (32 * w + nt * 16 + fr) * 72 + ks * 32 + fq * 8);
#pragma unroll
            for (int kt = 0; kt < 8; ++kt) {
                const bf16x8 a = *(const bf16x8*)(sKt + (kt * 16 + fr) * 72 + ks * 32 + fq * 8);
                st[kt][0] = mfma16(a, bb[0], st[kt][0]); st[kt][1] = mfma16(a, bb[1], st[kt][1]);
            }
        }
#pragma unroll
        for (int mt = 0; mt < 4; ++mt)
#pragma unroll
            for (int i = 0; i < 4; ++i) {
                float q = oacc[mt][0][i] * oacc[mt][0][i] + oacc[mt][1][i] * oacc[mt][1][i];
                q += __shfl_xor(q, 1); q += __shfl_xor(q, 2); q += __shfl_xor(q, 4); q += __shfl_xor(q, 8);
                if (fr == 0) sSsq[w * 64 + mt * 16 + fq * 4 + i] = q;
            }
        __syncthreads();
#pragma unroll
        for (int mt = 0; mt < 4; ++mt)
#pragma unroll
            for (int i = 0; i < 4; ++i) {
                const int t = mt * 16 + fq * 4 + i;
                const float tot = (sSsq[t] + sSsq[64 + t]) + (sSsq[128 + t] + sSsq[192 + t]);
                const float r = rsqrtf(tot * (1.f / 128.f) + LN_EPS);
#pragma unroll
                for (int nt = 0; nt < 2; ++nt) {
                    const int v = 32 * w + nt * 16 + fr;
                    const float gate = bf2f(H[(row_base + t) * 3072 + 2560 + h * 128 + v]);
                    YM[(row_base + t) * 1024 + 512 + h * 128 + v] = f2bf(oacc[mt][nt][i] * r * gn[v] * gate);
                }
            }
    }
}

template <int ROWS, int COLS, int LD>
DI void stage_tile(u16* s, const u16* g, int ld) {
    constexpr int CPR = COLS / 8, TOT = ROWS * CPR;
    const int tid = get_tid();
#pragma unroll
    for (int c0 = 0; c0 < TOT; c0 += 256) { const int c = c0 + tid, r = c / CPR, cc = (c % CPR) * 8; *(u32x4*)(s + r * LD + cc) = *(const u32x4*)(g + (size_t)r * ld + cc); }
}

template <int NDC, class MaskF>
DI void attn_keytile(const u16* Kg, int ldk, const u16* Vtg, int ldv, const bf16x8 (&bq)[NDC * 2], f32x4 (&oacc)[NDC * 4], float& m, float& l,
                     u16* sK, u16* sV, const MaskF& maskf, int fr, int fq) {
    f32x4 sacc[8];
#pragma unroll
    for (int i = 0; i < 8; ++i) sacc[i] = (f32x4){0.f, 0.f, 0.f, 0.f};
#pragma unroll
    for (int dc = 0; dc < NDC; ++dc) {
        __syncthreads();
        stage_tile<128, 64, 72>(sK, Kg + dc * 64, ldk);
        __syncthreads();
#pragma unroll
        for (int ks = 0; ks < 2; ++ks)
#pragma unroll
            for (int mt = 0; mt < 8; ++mt) { const bf16x8 a = *(const bf16x8*)(sK + (mt * 16 + fr) * 72 + ks * 32 + fq * 8); sacc[mt] = mfma16(a, bq[dc * 2 + ks], sacc[mt]); }
    }
    float mx = -1e30f;
#pragma unroll
    for (int mt = 0; mt < 8; ++mt)
#pragma unroll
        for (int i = 0; i < 4; ++i) { const float s = maskf(sacc[mt][i], mt * 16 + fq * 4 + i); sacc[mt][i] = s; mx = fmaxf(mx, s); }
    mx = fmaxf(mx, __shfl_xor(mx, 16)); mx = fmaxf(mx, __shfl_xor(mx, 32));
    const float mnew = fmaxf(m, mx), corr = __expf(m - mnew);
    l *= corr;
#pragma unroll
    for (int i = 0; i < NDC * 4; ++i) oacc[i] = oacc[i] * corr;
    float ps = 0.f;
#pragma unroll
    for (int mt = 0; mt < 8; ++mt)
#pragma unroll
        for (int i = 0; i < 4; ++i) { const float pe = __expf(sacc[mt][i] - mnew); ps += pe; sacc[mt][i] = pe; }
    l += ps; m = mnew;
    bf16x8 pb[4];
#pragma unroll
    for (int s = 0; s < 4; ++s) pb[s] = pack8(sacc[2 * s], sacc[2 * s + 1]);
#pragma unroll
    for (int dc = 0; dc < NDC; ++dc) {
        __syncthreads();
        stage_tile<64, 128, 136>(sV, Vtg + (size_t)dc * 64 * ldv, ldv);
        __syncthreads();
#pragma unroll
        for (int s = 0; s < 4; ++s)
#pragma unroll
            for (int mt = 0; mt < 4; ++mt) {
                const u16* va = sV + (mt * 16 + fr) * 136 + 32 * s + fq * 4;
                const bf16x8 a = mk8(*(const u32x2*)va, *(const u32x2*)(va + 16));
                oacc[dc * 4 + mt] = mfma16(a, pb[s], oacc[dc * 4 + mt]);
            }
    }
}

struct MaskNone { DI float operator()(float s, int) const { return s; } };
struct MaskMoba {
    int key0, tq, qblk; unsigned sel; float slope;
    DI float operator()(float s, int key) const {
        const int tk = key0 + key, j = key0 >> 8;
        const bool ok = (j < qblk) ? ((sel >> j) & 1u) : (tk <= tq);
        return ok ? s - slope * (float)(tq - tk) : -1e30f;
    }
};

DI void cross_item(const Params& p, int l, int item, char* lds) {
    const int tid = get_tid(), lane = tid & 63, w = tid >> 6, fr = lane & 15, fq = lane >> 4;
    const int qt = item & 31, h = (item >> 5) & 3, b = item >> 7;
    const u16* Q = (const u16*)(p.ws + O_H);
    const u16* Kd = (const u16*)(p.ws + O_KVK + l * 4 * MB);
    const u16* Vt = (const u16*)(p.ws + O_KVV + l * 4 * MB);
    u16* O = (u16*)(p.ws + O_YM);
    u16* sK = (u16*)lds; u16* sV = sK + 128 * 72;
    const size_t qrow = (size_t)b * SEQ + qt * 64 + w * 16 + fr;
    bf16x8 bq[8];
#pragma unroll
    for (int i = 0; i < 8; ++i) bq[i] = *(const bf16x8*)(Q + qrow * 1024 + h * 256 + i * 32 + fq * 8);
    f32x4 oacc[16];
#pragma unroll
    for (int i = 0; i < 16; ++i) oacc[i] = (f32x4){0.f, 0.f, 0.f, 0.f};
    float m = -1e30f, lsum = 0.f;
    MaskNone mk;
    for (int kt = 0; kt < 2; ++kt)
        attn_keytile<4>(Kd + ((size_t)b * 256 + kt * 128) * 1024 + h * 256, 1024, Vt + ((size_t)(b * 4 + h) * 256) * 256 + kt * 128, 256, bq, oacc, m, lsum, sK, sV, mk, fr, fq);
    lsum += __shfl_xor(lsum, 16); lsum += __shfl_xor(lsum, 32);
    const float inv = 1.f / lsum;
#pragma unroll
    for (int i = 0; i < 16; ++i) {
        u32x2 o; o.x = pack2(oacc[i][0] * inv, oacc[i][1] * inv); o.y = pack2(oacc[i][2] * inv, oacc[i][3] * inv);
        *(u32x2*)(O + qrow * 1024 + h * 256 + i * 16 + fq * 4) = o;
    }
}

DI void moba_item(const Params& p, int item, char* lds) {
    const int tid = get_tid(), lane = tid & 63, w = tid >> 6, fr = lane & 15, fq = lane >> 4;
    const int qt = 31 - (item >> 7), bh = item & 127, h = bh & 15, b = bh >> 4;
    const u16* Q = (const u16*)(p.ws + O_H);
    const u16* Kd = (const u16*)(p.ws + O_H + 32 * MB);
    const u16* Vt = (const u16*)(p.ws + O_H + 64 * MB);
    const float* KM = (const float*)(p.ws + O_KM);
    u16* O = (u16*)(p.ws + O_YM);
    u16* sK = (u16*)lds; u16* sV = sK + 128 * 72;
    const int q0 = qt * 64, qblk = q0 >> 8, tq = q0 + w * 16 + fr;
    const size_t qrow = (size_t)b * SEQ + tq;
    bf16x8 bq[2];
#pragma unroll
    for (int i = 0; i < 2; ++i) bq[i] = *(const bf16x8*)(Q + qrow * 1024 + h * 64 + i * 32 + fq * 8);
    unsigned sel = 0;
    if (qblk > 0) {
        float aff[8];
#pragma unroll
        for (int j = 0; j < 8; ++j) aff[j] = 0.f;
        const u16* qp = Q + qrow * 1024 + h * 64;
        const float* km = KM + (size_t)bh * 8 * 64;
#pragma unroll
        for (int d8 = 0; d8 < 8; ++d8) {
            const u32x4 qv = *(const u32x4*)(qp + d8 * 8);
            float qf[8];
#pragma unroll
            for (int e = 0; e < 4; ++e) { qf[2 * e] = __uint_as_float(qv[e] << 16); qf[2 * e + 1] = __uint_as_float(qv[e] & 0xffff0000u); }
#pragma unroll
            for (int j = 0; j < 7; ++j)
                if (j < qblk) {
#pragma unroll
                    for (int e = 0; e < 8; ++e) aff[j] += qf[e] * km[j * 64 + d8 * 8 + e];
                }
        }
#pragma unroll
        for (int j = 0; j < 7; ++j) {
            int rank = 0;
#pragma unroll
            for (int j2 = 0; j2 < 7; ++j2) if (j2 < qblk && j2 != j && (aff[j2] > aff[j] || (aff[j2] == aff[j] && j2 < j))) ++rank;
            if (j < qblk && rank < 3) sel |= 1u << j;
        }
    }
    f32x4 oacc[4];
#pragma unroll
    for (int i = 0; i < 4; ++i) oacc[i] = (f32x4){0.f, 0.f, 0.f, 0.f};
    float m = -1e30f, lsum = 0.f;
    MaskMoba mk; mk.tq = tq; mk.qblk = qblk; mk.sel = sel; mk.slope = exp2f(-0.5f * (float)(h + 1));
    for (int kt = q0 >> 7; kt >= 0; --kt) {
        mk.key0 = kt * 128;
        attn_keytile<1>(Kd + ((size_t)b * SEQ + kt * 128) * 1024 + h * 64, 1024, Vt + ((size_t)(b * 16 + h) * 64) * 2048 + kt * 128, 2048, bq, oacc, m, lsum, sK, sV, mk, fr, fq);
    }
    lsum += __shfl_xor(lsum, 16); lsum += __shfl_xor(lsum, 32);
    const float inv = 1.f / lsum;
#pragma unroll
    for (int i = 0; i < 4; ++i) {
        u32x2 o; o.x = pack2(oacc[i][0] * inv, oacc[i][1] * inv); o.y = pack2(oacc[i][2] * inv, oacc[i][3] * inv);
        *(u32x2*)(O + qrow * 1024 + h * 64 + i * 16 + fq * 4) = o;
    }
}

DI void kmean_item(const Params& p, int item, char* lds) {
    const int tid = get_tid(), d = tid & 63, part = tid >> 6;
    const int j = item & 7, bh = item >> 3, h = bh & 15, b = bh >> 4;
    const u16* Kd = (const u16*)(p.ws + O_H + 32 * MB) + ((size_t)b * SEQ + j * 256 + part * 64) * 1024 + h * 64 + d;
    float* red = (float*)lds;
    float s = 0.f;
#pragma unroll 8
    for (int i = 0; i < 64; ++i) s += bf2f(Kd[(size_t)i * 1024]);
    __syncthreads();
    red[part * 64 + d] = s;
    __syncthreads();
    if (part == 0) ((float*)(p.ws + O_KM))[(size_t)item * 64 + d] = ((red[d] + red[64 + d]) + (red[128 + d] + red[192 + d])) * (1.f / 256.f);
}

__global__ void __launch_bounds__(256, 2) mega(Params p) {
    extern __shared__ __attribute__((aligned(16))) char lds[];
    cg::grid_group grid = cg::this_grid();
    char* ws = p.ws;
    u16* XB = (u16*)(ws + O_XB); u16* Hb = (u16*)(ws + O_H); u16* YM = (u16*)(ws + O_YM);
    for (int ph = p.ph0; ph < p.ph1; ++ph) {
        const int l = ph >= 12 ? 1 : 0;
        switch (ph) {
        case 0: if (EN(0)) phase_prep(p, lds); break;
        case 1: {
            EpiH0 e0; e0.H = Hb; e0.lbl = p.in[16];
            gemm_phase(XB, 1024, (const u16*)(ws + O_WT_EVIN), 1024, 1024, 128, 24, 8, lds, e0, 0, 0);
            for (int l2 = 0; l2 < 2; ++l2) {
                EpiKV ek; ek.Kd = (u16*)(ws + O_KVK + l2 * 4 * MB); ek.Vt = (u16*)(ws + O_KVV + l2 * 4 * MB);
                gemm_phase((const u16*)(ws + O_MEMB), 1024, (const u16*)(ws + O_WT_WKV + l2 * 4 * MB), 1024, 1024, 16, 16, 2, lds, ek, 0, 3072 + l2 * 256);
            }
        } break;
        case 2: {
            for (int it = blockIdx.x; it < 32 + 512; it += gridDim.x) { if (it < 32) { if (EN(2)) hgrn_item(p, it, lds); } else { if (EN(3)) gmlp_item(p, it - 32, lds); } }
        } break;
        case 3: { EpiZ e; e.res = p.in[0]; e.out = p.out; gemm_phase(YM, 1024, (const u16*)(ws + O_WT_EVOUT), 1024, 1024, 128, 8, 8, lds, e, 0, 0); } break;
        case 4: case 8: case 11: case 16: case 20: case 23: {
            const int k = (ph == 4 || ph == 16) ? 0 : ((ph == 8 || ph == 20) ? 1 : 2);
            phase_ln(p.in[2] + (l * 3 + k) * 1024, p.in[3] + (l * 3 + k) * 1024, p.out, XB);
        } break;
        case 5: case 17: { EpiBf e; e.D = Hb; e.ld = 1024; e.scale = 0.0625f; gemm_phase(XB, 1024, (const u16*)(ws + O_WT_WQ + l * 2 * MB), 1024, 1024, 128, 8, 8, lds, e, 0, 0); } break;
        case 6: case 18: { for (int it = blockIdx.x; it < 1024; it += gridDim.x) if (EN(6)) cross_item(p, l, it, lds); } break;
        case 7: case 19: { EpiZ e; e.res = p.out; e.out = p.out; gemm_phase(YM, 1024, (const u16*)(ws + O_WT_WO + l * 2 * MB), 1024, 1024, 128, 8, 8, lds, e, 0, 0); } break;
        case 9: case 21: { EpiFFN e; e.Hd = Hb; gemm_phase(XB, 1024, (const u16*)(ws + O_WT_FIN + l * 11 * MB), 1024, 1024, 128, 44, 8, lds, e, 0, 0); } break;
        case 10: case 22: { EpiZ e; e.res = p.out; e.out = p.out; gemm_phase(Hb, DFF, (const u16*)(ws + O_WT_FOUT + l * (11 * MB / 2)), DFF, DFF, 128, 8, 8, lds, e, 0, 0); } break;
        case 12: { EpiQKV1 e; e.Q = Hb; e.Kd = (u16*)(ws + O_H + 32 * MB); e.Vt = (u16*)(ws + O_H + 64 * MB); gemm_phase(XB, 1024, (const u16*)(ws + O_WT_QKV), 1024, 1024, 128, 24, 8, lds, e, 0, 0); } break;
        case 13: { for (int it = blockIdx.x; it < 1024; it += gridDim.x) kmean_item(p, it, lds); } break;
        case 14: { for (int it = blockIdx.x; it < 4096; it += gridDim.x) if (EN(14)) moba_item(p, it, lds); } break;
        case 15: { EpiZ e; e.res = p.out; e.out = p.out; gemm_phase(YM, 1024, (const u16*)(ws + O_WT_ODOUT), 1024, 1024, 128, 8, 8, lds, e, 0, 0); } break;
        default: break;
        }
        if (ph + 1 < p.ph1) grid.sync();
    }
}

extern "C" void kernel_launch(void* const* d_in, const int* in_sizes, int n_in, void* d_out, int out_size, void* d_ws, size_t ws_size, hipStream_t stream) {
    static int grid = 0;
    if (grid == 0) {
        if (n_in != 19 || ws_size < WS_END) { fprintf(stderr, "kernel_launch: unexpected n_in %d / ws %zu (need %zu)\n", n_in, ws_size, (size_t)WS_END); grid = -1; return; }
        int dev = 0, cus = 0, per_cu = 0;
        hipGetDevice(&dev);
        hipDeviceGetAttribute(&cus, hipDeviceAttributeMultiprocessorCount, dev);
        if (hipFuncSetAttribute((const void*)mega, hipFuncAttributeMaxDynamicSharedMemorySize, LDS_BYTES) != hipSuccess) { fprintf(stderr, "hipFuncSetAttribute failed\n"); grid = -1; return; }
        if (hipOccupancyMaxActiveBlocksPerMultiprocessor(&per_cu, (const void*)mega, 256, LDS_BYTES) != hipSuccess || per_cu < 1) { fprintf(stderr, "occupancy query failed\n"); grid = -1; return; }
        if (per_cu > 2) per_cu = 2;
        grid = cus * per_cu;
        grid -= grid % 8;
        fprintf(stderr, "kernel_launch: grid %d (cus %d per_cu %d)\n", grid, cus, per_cu);
    }
    if (grid < 0) return;
    Params p{};
    for (int i = 0; i < 19; ++i) p.in[i] = (const float*)d_in[i];
    p.out = (float*)d_out; p.ws = (char*)d_ws;
#if MULTI_LAUNCH
    for (int ph = 0; ph < NPHASE; ++ph) {
        p.ph0 = ph; p.ph1 = ph + 1;
        hipLaunchKernelGGL(mega, dim3(grid), dim3(256), LDS_BYTES, stream, p);
    }
#else
    p.ph0 = 0; p.ph1 = NPHASE;
    void* args[] = {&p};
    hipError_t e = hipLaunchCooperativeKernel((void*)mega, dim3(grid), dim3(256), args, LDS_BYTES, stream);
    if (e != hipSuccess) fprintf(stderr, "cooperative launch failed: %s (grid %d)\n", hipGetErrorString(e), grid);
#endif
}
```

```cpp
#include <hip/hip_runtime.h>
#include <hip/hip_cooperative_groups.h>
#include <cstdio>
#include <cstdint>
namespace cg = cooperative_groups;

#ifndef MULTI_LAUNCH
#define MULTI_LAUNCH 0
#endif

#ifndef PHMASK
#define PHMASK 0xFFFFFFFFu
#endif
#define EN(x) ((PHMASK >> (x)) & 1u)
#define DI __device__ __forceinline__
typedef unsigned short u16;
typedef short bf16x8 __attribute__((ext_vector_type(8)));
typedef float f32x4 __attribute__((ext_vector_type(4)));
typedef unsigned u32x4 __attribute__((ext_vector_type(4)));
typedef unsigned u32x2 __attribute__((ext_vector_type(2)));

constexpr int NT = 16384, DM = 1024, SEQ = 2048;
constexpr int DFF = 2816;
constexpr float ALPHA = 1.41421356237309515f;
constexpr float LN_EPS = 1e-5f;
constexpr int LDS_MAIN = 73728;
constexpr int LDS_BYTES = LDS_MAIN + 16;
constexpr int NPHASE = 24;

constexpr size_t MB = 1u << 20;
constexpr size_t O_WT_EVIN = 0;
constexpr size_t O_WT_EVOUT = O_WT_EVIN + 6 * MB;
constexpr size_t O_WT_WQ = O_WT_EVOUT + 2 * MB;
constexpr size_t O_WT_WKV = O_WT_WQ + 4 * MB;
constexpr size_t O_WT_WO = O_WT_WKV + 8 * MB;
constexpr size_t O_WT_FIN = O_WT_WO + 4 * MB;
constexpr size_t O_WT_FOUT = O_WT_FIN + 22 * MB;
constexpr size_t O_WT_QKV = O_WT_FOUT + 11 * MB;
constexpr size_t O_WT_ODOUT = O_WT_QKV + 6 * MB;
constexpr size_t O_XB = O_WT_ODOUT + 2 * MB;
constexpr size_t O_H = O_XB + 32 * MB;
constexpr size_t O_YM = O_H + 96 * MB;
constexpr size_t O_MEMB = O_YM + 32 * MB;
constexpr size_t O_KVK = O_MEMB + 4 * MB;
constexpr size_t O_KVV = O_KVK + 8 * MB;
constexpr size_t O_KM = O_KVV + 8 * MB;
constexpr size_t O_BAR = O_KM + MB;
constexpr size_t WS_END = O_BAR + MB;

struct Params { const float* in[19]; float* out; char* ws; int ph0, ph1; int use_cg, pad; };

DI int get_tid() { int t = threadIdx.x; asm volatile("" : "+v"(t)); return t; }
DI u16 f2bf(float x) { unsigned u = __float_as_uint(x); u += 0x7fffu + ((u >> 16) & 1u); return (u16)(u >> 16); }
DI float bf2f(u16 h) { return __uint_as_float(((unsigned)h) << 16); }
DI unsigned pack2(float a, float b) { return (unsigned)f2bf(a) | ((unsigned)f2bf(b) << 16); }
DI f32x4 mfma16(bf16x8 a, bf16x8 b, f32x4 c) { return __builtin_amdgcn_mfma_f32_16x16x32_bf16(a, b, c, 0, 0, 0); }
DI bf16x8 mk8(u32x2 lo, u32x2 hi) { u32x4 t; t.x = lo.x; t.y = lo.y; t.z = hi.x; t.w = hi.y; return __builtin_bit_cast(bf16x8, t); }
DI bf16x8 pack8(f32x4 a, f32x4 b) { u32x4 t; t.x = pack2(a[0], a[1]); t.y = pack2(a[2], a[3]); t.z = pack2(b[0], b[1]); t.w = pack2(b[2], b[3]); return __builtin_bit_cast(bf16x8, t); }
DI float gelu_tanh(float x) { float y = 0.7978845608028654f * (x + 0.044715f * x * x * x); float t = 1.f - 2.f / (1.f + __expf(2.f * y)); return 0.5f * x * (1.f + t); }
DI float sigmoidf(float x) { return 1.f / (1.f + __expf(-x)); }
DI float siluf(float x) { return x / (1.f + __expf(-x)); }


#define XB_TMO      128
#define XB_XCNT(j)  (256  + 64 * (j))
#define XB_XSUB(j)  (1280 + 64 * (j))
#define XB_XGEN(j)  (2304 + 64 * (j))
#define XB_TOP      3328
#define XB_TOPGEN   3392
#define XCD_BAR_WORDS 3456
#define XB_SPIN_CAP (1u << 18)
#define LAS __attribute__((address_space(3)))
DI unsigned xb_ld(unsigned* p) { return __hip_atomic_load(p, __ATOMIC_RELAXED, __HIP_MEMORY_SCOPE_AGENT); }
DI unsigned xb_add(unsigned* p, unsigned v) { return __hip_atomic_fetch_add(p, v, __ATOMIC_RELAXED, __HIP_MEMORY_SCOPE_AGENT); }
DI unsigned xb_xcc_id() { return (unsigned)__builtin_amdgcn_s_getreg((3 << 11) | 20) & 0xFu; }
#define XB_SPIN(cond, bar) do { unsigned _sp = 0; while (cond) { __builtin_amdgcn_s_sleep(1); \
    if ((++_sp & 255u) == 0u) { if (xb_ld(&(bar)[XB_TMO])) break; if (_sp > XB_SPIN_CAP) { atomicAdd(&(bar)[XB_TMO], 1u); break; } } } } while (0)
struct XcdBarrier { unsigned* bar; unsigned x; volatile LAS unsigned* st; };
DI XcdBarrier xcd_barrier_post(unsigned* bar, volatile LAS unsigned* st) {
    XcdBarrier b; b.bar = bar; b.x = xb_xcc_id(); b.st = st;
    if (threadIdx.x == 0) (void)xb_add(&bar[XB_XCNT(b.x)], 1u);
    return b;
}
DI void xcd_barrier_complete(unsigned* bar, unsigned x, unsigned& nloc, unsigned& nx) {
    const unsigned G = gridDim.x * gridDim.y * gridDim.z;
    unsigned sum, cnt, mine, sp = 0u;
    for (;;) {
        sum = 0u; cnt = 0u; mine = 0u;
#pragma unroll
        for (unsigned j = 0; j < 16; ++j) { const unsigned c = xb_ld(&bar[XB_XCNT(j)]); sum += c; cnt += (c > 0u) ? 1u : 0u; mine = (j == x) ? c : mine; }
        if (sum == G) break;
        __builtin_amdgcn_s_sleep(1);
        if ((++sp & 255u) == 0u) { if (xb_ld(&bar[XB_TMO])) break; if (sp > XB_SPIN_CAP) { atomicAdd(&bar[XB_TMO], 1u); break; } }
    }
    nloc = mine > 0u ? mine : 1u; nx = cnt > 0u ? cnt : 1u;
}
DI void xcd_barrier(const XcdBarrier& b) {
    asm volatile("s_waitcnt vmcnt(0)" ::: "memory");
    __syncthreads();
    if (threadIdx.x == 0) {
        unsigned* bar = b.bar;
        __builtin_amdgcn_s_waitcnt(0);
        unsigned nloc = b.st[0], nx = b.st[1];
        if (nloc == 0u) { xcd_barrier_complete(bar, b.x, nloc, nx); b.st[0] = nloc; b.st[1] = nx; }
        const unsigned old = xb_add(&bar[XB_XSUB(b.x)], 1u);
        const unsigned gen = old / nloc;
        if (old + 1u == (gen + 1u) * nloc) {
            __builtin_amdgcn_fence(__ATOMIC_RELEASE, "agent");
            asm volatile("s_waitcnt vmcnt(0)" ::: "memory");
            const unsigned og = xb_add(&bar[XB_TOP], 1u);
            const unsigned tg = og / nx;
            if (og + 1u == (tg + 1u) * nx) xb_add(&bar[XB_TOPGEN], 1u);
            else XB_SPIN(xb_ld(&bar[XB_TOPGEN]) == tg, bar);
            __builtin_amdgcn_fence(__ATOMIC_ACQUIRE, "agent");
            xb_add(&bar[XB_XGEN(b.x)], 1u);
            asm volatile("s_waitcnt vmcnt(0)" ::: "memory");
        } else {
            XB_SPIN(xb_ld(&bar[XB_XGEN(b.x)]) == gen, bar);
            __builtin_amdgcn_fence(__ATOMIC_ACQUIRE, "agent");
            asm volatile("s_waitcnt vmcnt(0)" ::: "memory");
        }
    }
    __syncthreads();
}

constexpr int LDT = 72;
DI void tile_map(int t, int nN, int GM, int& pm, int& pn) {
    const int x = t & 7, idx = t >> 3;
    const int per_group = GM * nN, g = idx / per_group, r = idx % per_group;
    pm = x + 8 * (g * GM + (r % GM)); pn = r / GM;
}

template <class Epi>
DI void gemm_tile(const u16* __restrict__ A, int lda, const u16* __restrict__ Bt, int ldb, int K, int row0, int col0, char* lds, const Epi& epi) {
    const int tid = get_tid(), lane = tid & 63, w = tid >> 6, wr = w >> 1, wc = w & 1, fr = lane & 15, fq = lane >> 4;
    u16* sA = (u16*)lds;
    u16* sB = sA + 2 * 128 * LDT;
    const int lr = tid >> 3, lc = (tid & 7) * 8;
    const u16* gA = A + (size_t)(row0 + lr) * lda + lc;
    const u16* gB = Bt + (size_t)(col0 + lr) * ldb + lc;
    u32x4 ra[4], rb[4];
    f32x4 acc[4][4];
#pragma unroll
    for (int i = 0; i < 4; ++i)
#pragma unroll
        for (int j = 0; j < 4; ++j) acc[i][j] = (f32x4){0.f, 0.f, 0.f, 0.f};
    const int nk = K >> 6;
#ifdef GREP
    for (int rep = 0; rep < GREP; ++rep) {
    if (rep) {
#pragma unroll
        for (int i = 0; i < 4; ++i)
#pragma unroll
            for (int j = 0; j < 4; ++j) acc[i][j] = acc[i][j] * 0.f;
    }
#endif
#pragma unroll
    for (int i = 0; i < 4; ++i) { ra[i] = *(const u32x4*)(gA + (size_t)i * 32 * lda); rb[i] = *(const u32x4*)(gB + (size_t)i * 32 * ldb); }
#pragma unroll
    for (int i = 0; i < 4; ++i) { *(u32x4*)(sA + (lr + i * 32) * LDT + lc) = ra[i]; *(u32x4*)(sB + (lr + i * 32) * LDT + lc) = rb[i]; }
    __syncthreads();
    for (int kt = 0; kt < nk; ++kt) {
        const int st = kt & 1;
        if (kt + 1 < nk) {
#pragma unroll
            for (int i = 0; i < 4; ++i) { ra[i] = *(const u32x4*)(gA + (size_t)i * 32 * lda + (kt + 1) * 64); rb[i] = *(const u32x4*)(gB + (size_t)i * 32 * ldb + (kt + 1) * 64); }
        }
        const u16* cA = sA + st * 128 * LDT + (wr * 64 + fr) * LDT + fq * 8;
        const u16* cB = sB + st * 128 * LDT + (wc * 64 + fr) * LDT + fq * 8;
#pragma unroll
        for (int ks = 0; ks < 2; ++ks) {
            bf16x8 a[4], b[4];
#pragma unroll
            for (int i = 0; i < 4; ++i) { a[i] = *(const bf16x8*)(cA + i * 16 * LDT + ks * 32); b[i] = *(const bf16x8*)(cB + i * 16 * LDT + ks * 32); }
#pragma unroll
            for (int i = 0; i < 4; ++i)
#pragma unroll
                for (int j = 0; j < 4; ++j) acc[i][j] = mfma16(a[i], b[j], acc[i][j]);
        }
        if (kt + 1 < nk) {
            const int s2 = st ^ 1;
#pragma unroll
            for (int i = 0; i < 4; ++i) { *(u32x4*)(sA + s2 * 128 * LDT + (lr + i * 32) * LDT + lc) = ra[i]; *(u32x4*)(sB + s2 * 128 * LDT + (lr + i * 32) * LDT + lc) = rb[i]; }
        }
        __syncthreads();
    }
#ifdef GREP
    }
#endif
    epi(acc, row0 + wr * 64, col0 + wc * 64, fr, fq);
}

#define EPI_LOOP _Pragma("unroll") for (int mi = 0; mi < 4; ++mi) _Pragma("unroll") for (int ni = 0; ni < 4; ++ni) _Pragma("unroll") for (int i = 0; i < 4; ++i)

struct EpiH0 {
    u16* H; const float* lbl;
    DI void operator()(const f32x4 (&acc)[4][4], int rb, int cb, int fr, int fq) const {
        const int region = cb >> 9;
        EPI_LOOP {
            const int row = rb + mi * 16 + fq * 4 + i, col = cb + ni * 16 + fr;
            float v = acc[mi][ni][i];
            if (region <= 1) v = gelu_tanh(v);
            else if (region == 3) { const int c = col - 1536; const float lb = 1.f / (1.f + __expf(lbl[512 + c] - lbl[c])); v = __logf(lb + (1.f - lb) * sigmoidf(v)); }
            else if (region >= 4) v = siluf(v);
            H[(size_t)row * 3072 + col] = f2bf(v);
        }
    }
};
struct EpiKV {
    u16* Kd; u16* Vt;
    DI void operator()(const f32x4 (&acc)[4][4], int rb, int cb, int fr, int fq) const {
        if (cb < 1024) {
            EPI_LOOP { const int row = rb + mi * 16 + fq * 4 + i, col = cb + ni * 16 + fr; Kd[(size_t)row * 1024 + col] = f2bf(acc[mi][ni][i]); }
        } else {
#pragma unroll
            for (int mi = 0; mi < 4; ++mi)
#pragma unroll
                for (int ni = 0; ni < 4; ++ni) {
                    const int row = rb + mi * 16 + fq * 4, c = cb - 1024 + ni * 16 + fr, b = row >> 8, m = row & 255, h = c >> 8, d = c & 255;
                    u32x2 o; o.x = pack2(acc[mi][ni][0], acc[mi][ni][1]); o.y = pack2(acc[mi][ni][2], acc[mi][ni][3]);
                    *(u32x2*)(Vt + ((size_t)((b * 4 + h) * 256 + d)) * 256 + m) = o;
                }
        }
    }
};
struct EpiZ {
    const float* res; float* out;
    DI void operator()(const f32x4 (&acc)[4][4], int rb, int cb, int fr, int fq) const {
        EPI_LOOP { const size_t o = (size_t)(rb + mi * 16 + fq * 4 + i) * 1024 + cb + ni * 16 + fr; out[o] = ALPHA * res[o] + acc[mi][ni][i]; }
    }
};
struct EpiBf {
    u16* D; int ld; float scale;
    DI void operator()(const f32x4 (&acc)[4][4], int rb, int cb, int fr, int fq) const {
        EPI_LOOP { D[(size_t)(rb + mi * 16 + fq * 4 + i) * ld + cb + ni * 16 + fr] = f2bf(acc[mi][ni][i] * scale); }
    }
};
struct EpiFFN {
    u16* Hd;
    DI void operator()(const f32x4 (&acc)[4][4], int rb, int cb, int fr, int fq) const {
        const int grp = cb >> 6;
#pragma unroll
        for (int mi = 0; mi < 4; ++mi)
#pragma unroll
            for (int ni = 0; ni < 2; ++ni)
#pragma unroll
                for (int i = 0; i < 4; ++i) {
                    const float g = acc[mi][ni][i], u = acc[mi][ni + 2][i];
                    Hd[(size_t)(rb + mi * 16 + fq * 4 + i) * DFF + grp * 32 + ni * 16 + fr] = f2bf(siluf(g) * u);
                }
    }
};
struct EpiQKV1 {
    u16* Q; u16* Kd; u16* Vt;
    DI void operator()(const f32x4 (&acc)[4][4], int rb, int cb, int fr, int fq) const {
        if (cb < 1024) {
            EPI_LOOP { Q[(size_t)(rb + mi * 16 + fq * 4 + i) * 1024 + cb + ni * 16 + fr] = f2bf(acc[mi][ni][i] * 0.125f); }
        } else if (cb < 2048) {
            EPI_LOOP { Kd[(size_t)(rb + mi * 16 + fq * 4 + i) * 1024 + cb - 1024 + ni * 16 + fr] = f2bf(acc[mi][ni][i]); }
        } else {
#pragma unroll
            for (int mi = 0; mi < 4; ++mi)
#pragma unroll
                for (int ni = 0; ni < 4; ++ni) {
                    const int row = rb + mi * 16 + fq * 4, c = cb - 2048 + ni * 16 + fr, b = row >> 11, t = row & 2047, h = c >> 6, d = c & 63;
                    u32x2 o; o.x = pack2(acc[mi][ni][0], acc[mi][ni][1]); o.y = pack2(acc[mi][ni][2], acc[mi][ni][3]);
                    *(u32x2*)(Vt + ((size_t)((b * 16 + h) * 64 + d)) * 2048 + t) = o;
                }
        }
    }
};

template <class Epi>
DI void gemm_phase(const u16* A, int lda, const u16* Bt, int ldb, int K, int nM, int nN, int GM, char* lds, const Epi& epi, int t_begin, int t_total_before) {
    (void)t_begin;
    const int ntile = nM * nN;
    for (int t = blockIdx.x; t < t_total_before + ntile; t += gridDim.x) {
        if (t < t_total_before) continue;
        int pm, pn; tile_map(t - t_total_before, nN, GM, pm, pn);
        gemm_tile(A, lda, Bt, ldb, K, pm * 128, pn * 128, lds, epi);
    }
}

DI void transpose_item(const float* __restrict__ W, int K, int N, u16* __restrict__ WT, int perm, int item, float* scr) {
    const int ntn = N >> 6, kb = item / ntn, nb = item % ntn, k0 = kb * 64, n0 = nb * 64, tid = get_tid();
    __syncthreads();
#pragma unroll
    for (int i = 0; i < 16; ++i) { const int kk = i * 4 + (tid >> 6), nn = tid & 63; scr[kk * 65 + nn] = W[(size_t)(k0 + kk) * N + n0 + nn]; }
    __syncthreads();
    const int n = tid >> 2, c = tid & 3;
    const float* s = scr + (c * 16) * 65 + n;
    u32x4 o0, o1;
    o0.x = pack2(s[0 * 65], s[1 * 65]); o0.y = pack2(s[2 * 65], s[3 * 65]); o0.z = pack2(s[4 * 65], s[5 * 65]); o0.w = pack2(s[6 * 65], s[7 * 65]);
    o1.x = pack2(s[8 * 65], s[9 * 65]); o1.y = pack2(s[10 * 65], s[11 * 65]); o1.z = pack2(s[12 * 65], s[13 * 65]); o1.w = pack2(s[14 * 65], s[15 * 65]);
    int nsrc = n0 + n, drow = nsrc;
    if (perm) { if (nsrc < DFF) drow = (nsrc >> 5) * 64 + (nsrc & 31); else { const int n2 = nsrc - DFF; drow = (n2 >> 5) * 64 + 32 + (n2 & 31); } }
    u32x4* dst = (u32x4*)(WT + (size_t)drow * K + k0 + c * 16);
    dst[0] = o0; dst[1] = o1;
}

DI void phase_prep(const Params& p, char* lds) {
    float* scr = (float*)lds;
    char* ws = p.ws;
    constexpr int T1 = 16 * 48, TS = 16 * 16, TKV = 16 * 32, TFI = 16 * 88, TFO = 44 * 16;
    constexpr int NTR = T1 + TS + 2 * TS + 2 * TKV + 2 * TS + 2 * TFI + 2 * TFO + T1 + TS;
    constexpr int NXC = NT * DM / 2048, NMC = 2048 * DM / 2048;
    for (int it = blockIdx.x; it < NTR + NXC + NMC; it += gridDim.x) {
        int r = it;
        if (r < NTR) {
            if (r < T1) { transpose_item(p.in[9], 1024, 3072, (u16*)(ws + O_WT_EVIN), 0, r, scr); continue; } r -= T1;
            if (r < TS) { transpose_item(p.in[10], 1024, 1024, (u16*)(ws + O_WT_EVOUT), 0, r, scr); continue; } r -= TS;
            if (r < 2 * TS) { const int l = r / TS; transpose_item(p.in[4] + (size_t)l * 1024 * 1024, 1024, 1024, (u16*)(ws + O_WT_WQ + l * 2 * MB), 0, r % TS, scr); continue; } r -= 2 * TS;
            if (r < 2 * TKV) { const int l = r / TKV; transpose_item(p.in[5] + (size_t)l * 1024 * 2048, 1024, 2048, (u16*)(ws + O_WT_WKV + l * 4 * MB), 0, r % TKV, scr); continue; } r -= 2 * TKV;
            if (r < 2 * TS) { const int l = r / TS; transpose_item(p.in[6] + (size_t)l * 1024 * 1024, 1024, 1024, (u16*)(ws + O_WT_WO + l * 2 * MB), 0, r % TS, scr); continue; } r -= 2 * TS;
            if (r < 2 * TFI) { const int l = r / TFI; transpose_item(p.in[7] + (size_t)l * 1024 * 5632, 1024, 5632, (u16*)(ws + O_WT_FIN + l * 11 * MB), 1, r % TFI, scr); continue; } r -= 2 * TFI;
            if (r < 2 * TFO) { const int l = r / TFO; transpose_item(p.in[8] + (size_t)l * 2816 * 1024, 2816, 1024, (u16*)(ws + O_WT_FOUT + l * (11 * MB / 2)), 0, r % TFO, scr); continue; } r -= 2 * TFO;
            if (r < T1) { transpose_item(p.in[17], 1024, 3072, (u16*)(ws + O_WT_QKV), 0, r, scr); continue; } r -= T1;
            transpose_item(p.in[18], 1024, 1024, (u16*)(ws + O_WT_ODOUT), 0, r, scr);
            continue;
        }
        r -= NTR;
        const float* src; u16* dst;
        if (r < NXC) { src = p.in[0]; dst = (u16*)(ws + O_XB); } else { r -= NXC; src = p.in[1]; dst = (u16*)(ws + O_MEMB); }
        const size_t e = (size_t)r * 2048 + get_tid() * 8;
        const f32x4 a = *(const f32x4*)(src + e), b = *(const f32x4*)(src + e + 4);
        u32x4 o; o.x = pack2(a[0], a[1]); o.y = pack2(a[2], a[3]); o.z = pack2(b[0], b[1]); o.w = pack2(b[2], b[3]);
        *(u32x4*)(dst + e) = o;
    }
}

DI void phase_ln(const float* __restrict__ g, const float* __restrict__ bta, float* xio, u16* xb) {
    const int tid = get_tid(), lane = tid & 63, gw = blockIdx.x * 4 + (tid >> 6), nw = gridDim.x * 4;
    for (int row = gw; row < NT; row += nw) {
        f32x4* xr = (f32x4*)(xio + (size_t)row * 1024);
        f32x4 v[4]; float s = 0.f;
#pragma unroll
        for (int j = 0; j < 4; ++j) { v[j] = xr[lane + 64 * j]; s += (v[j][0] + v[j][1]) + (v[j][2] + v[j][3]); }
#pragma unroll
        for (int o = 1; o < 64; o <<= 1) s += __shfl_xor(s, o);
        const float mean = s * (1.f / 1024.f); float q = 0.f;
#pragma unroll
        for (int j = 0; j < 4; ++j) { v[j] = v[j] - mean; q += (v[j][0] * v[j][0] + v[j][1] * v[j][1]) + (v[j][2] * v[j][2] + v[j][3] * v[j][3]); }
#pragma unroll
        for (int o = 1; o < 64; o <<= 1) q += __shfl_xor(q, o);
        const float rstd = rsqrtf(q * (1.f / 1024.f) + LN_EPS);
#pragma unroll
        for (int j = 0; j < 4; ++j) {
            const f32x4 gg = ((const f32x4*)g)[lane + 64 * j], bb = ((const f32x4*)bta)[lane + 64 * j];
            const f32x4 y = v[j] * rstd * gg + bb;
            xr[lane + 64 * j] = y;
            u32x2 o; o.x = pack2(y[0], y[1]); o.y = pack2(y[2], y[3]);
            ((u32x2*)(xb + (size_t)row * 1024))[lane + 64 * j] = o;
        }
    }
}

DI void gmlp_item(const Params& p, int item, char* lds) {
    const int tid = get_tid(), lane = tid & 63, w = tid >> 6, wr = w >> 1, wc = w & 1, fr = lane & 15, fq = lane >> 4;
    const int g = item & 3, n = (item >> 2) & 15, b = item >> 6;
    const u16* H = (const u16*)(p.ws + O_H);
    u16* YM = (u16*)(p.ws + O_YM);
    u16* sW = (u16*)lds; u16* sV = sW + 128 * 136;
    const size_t row_base = (size_t)b * SEQ + n * 128;
    __syncthreads();
    {
        const float* Wg = p.in[11] + (size_t)g * 128 * 128;
#pragma unroll 4
        for (int c = tid; c < 128 * 32; c += 256) {
            const int t = c >> 5, s4 = (c & 31) * 4;
            const f32x4 v = *(const f32x4*)(Wg + t * 128 + s4);
            u32x2 o; o.x = pack2(s4 + 0 <= t ? v[0] : 0.f, s4 + 1 <= t ? v[1] : 0.f); o.y = pack2(s4 + 2 <= t ? v[2] : 0.f, s4 + 3 <= t ? v[3] : 0.f);
            *(u32x2*)(sW + t * 136 + s4) = o;
        }
    }
    {
        const int r = tid >> 1, half = tid & 1;
        const u16* src = H + (row_base + r) * 3072 + 512 + g * 128 + half * 64;
        float x[64]; float s = 0.f;
#pragma unroll
        for (int j = 0; j < 8; ++j) {
            const u32x4 q = *(const u32x4*)(src + j * 8);
#pragma unroll
            for (int e = 0; e < 4; ++e) { x[j * 8 + 2 * e] = __uint_as_float(q[e] << 16); x[j * 8 + 2 * e + 1] = __uint_as_float(q[e] & 0xffff0000u); }
        }
#pragma unroll
        for (int j = 0; j < 64; ++j) s += x[j];
        s += __shfl_xor(s, 1);
        const float mean = s * (1.f / 128.f); float q2 = 0.f;
#pragma unroll
        for (int j = 0; j < 64; ++j) { x[j] -= mean; q2 += x[j] * x[j]; }
        q2 += __shfl_xor(q2, 1);
        const float rstd = rsqrtf(q2 * (1.f / 128.f) + LN_EPS);
        const float* lg = p.in[13] + g * 128 + half * 64; const float* lb = p.in[14] + g * 128 + half * 64;
#pragma unroll
        for (int j = 0; j < 64; ++j) sV[(half * 64 + j) * 136 + r] = f2bf(x[j] * rstd * lg[j] + lb[j]);
    }
    __syncthreads();
    f32x4 acc[4][4];
#pragma unroll
    for (int i = 0; i < 4; ++i)
#pragma unroll
        for (int j = 0; j < 4; ++j) acc[i][j] = (f32x4){0.f, 0.f, 0.f, 0.f};
    const u16* cA = sW + (wr * 64 + fr) * 136 + fq * 8;
    const u16* cB = sV + (wc * 64 + fr) * 136 + fq * 8;
#pragma unroll
    for (int ks = 0; ks < 4; ++ks) {
        bf16x8 a[4], bb[4];
#pragma unroll
        for (int i = 0; i < 4; ++i) { a[i] = *(const bf16x8*)(cA + i * 16 * 136 + ks * 32); bb[i] = *(const bf16x8*)(cB + i * 16 * 136 + ks * 32); }
#pragma unroll
        for (int i = 0; i < 4; ++i)
#pragma unroll
            for (int j = 0; j < 4; ++j) acc[i][j] = mfma16(a[i], bb[j], acc[i][j]);
    }
    const float* bs = p.in[12] + g * 128;
#pragma unroll
    for (int mi = 0; mi < 4; ++mi)
#pragma unroll
        for (int i = 0; i < 4; ++i) {
            const int t = wr * 64 + mi * 16 + fq * 4 + i; const float bt = bs[t];
#pragma unroll
            for (int ni = 0; ni < 4; ++ni) {
                const int c = wc * 64 + ni * 16 + fr;
                const float u = bf2f(H[(row_base + t) * 3072 + g * 128 + c]);
                YM[(row_base + t) * 1024 + g * 128 + c] = f2bf(u * (acc[mi][ni][i] + bt));
            }
        }
}

DI void hgrn_item(const Params& p, int item, char* lds) {
    const int tid = get_tid(), lane = tid & 63, w = tid >> 6, fr = lane & 15, fq = lane >> 4;
    const int h = item & 3, b = item >> 2;
    const u16* H = (const u16*)(p.ws + O_H);
    u16* YM = (u16*)(p.ws + O_YM);
    u16* sQ = (u16*)lds;
    u16* sKd = sQ + 64 * 136;
    u16* sKt = sKd + 64 * 136;
    u16* sI = sKt + 128 * 72;
    float* sDec = (float*)(sI + 128 * 72);
    float* sTot = sDec + 128;
    u16* sAt = sKd;
    float* sSsq = (float*)(sKd + 64 * 72);
    const float* gn = p.in[15] + h * 128;
    f32x4 st[8][2];
#pragma unroll
    for (int i = 0; i < 8; ++i) { st[i][0] = (f32x4){0.f, 0.f, 0.f, 0.f}; st[i][1] = (f32x4){0.f, 0.f, 0.f, 0.f}; }
    const int ch = tid & 127, th = tid >> 7;
    for (int n = 0; n < 32; ++n) {
        const size_t row_base = (size_t)b * SEQ + n * 64;
        __syncthreads();
        {
            const u16* src = H + (row_base + th * 32) * 3072 + h * 128 + ch;
            float cum[32];
            float run = 0.f;
#pragma unroll
            for (int j = 0; j < 32; ++j) { run += bf2f(src[(size_t)j * 3072 + 1536]); cum[j] = run; }
            sTot[th * 128 + ch] = run;
            __syncthreads();
            const float t0 = sTot[ch], t1 = sTot[128 + ch], total = t0 + t1, off = th ? t0 : 0.f;
            if (th == 0) sDec[ch] = __expf(total);
            unsigned kt[16], iv[16];
            float prev = off;
#pragma unroll
            for (int j = 0; j < 32; ++j) {
                const float c = cum[j] + off;
                const float lf = c - prev; prev = c;
                const float q = bf2f(src[(size_t)j * 3072 + 1024]);
                const float iv_ = bf2f(src[(size_t)j * 3072 + 2048]);
                const float kc = 1.f - __expf(lf);
                sQ[(th * 32 + j) * 136 + ch] = f2bf(q * __expf(c));
                sKd[(th * 32 + j) * 136 + ch] = f2bf(kc * __expf(-c));
                const unsigned ktv = f2bf(kc * __expf(total - c)), ivv = f2bf(iv_);
                if (j & 1) { kt[j >> 1] |= ktv << 16; iv[j >> 1] |= ivv << 16; } else { kt[j >> 1] = ktv; iv[j >> 1] = ivv; }
            }
#pragma unroll
            for (int j = 0; j < 4; ++j) {
                *(u32x4*)(sKt + ch * 72 + th * 32 + j * 8) = (u32x4){kt[4 * j], kt[4 * j + 1], kt[4 * j + 2], kt[4 * j + 3]};
                *(u32x4*)(sI + ch * 72 + th * 32 + j * 8) = (u32x4){iv[4 * j], iv[4 * j + 1], iv[4 * j + 2], iv[4 * j + 3]};
            }
        }
        __syncthreads();
        f32x4 at[4];
#pragma unroll
        for (int nt = 0; nt < 4; ++nt) at[nt] = (f32x4){0.f, 0.f, 0.f, 0.f};
#pragma unroll
        for (int ks = 0; ks < 4; ++ks) {
            const bf16x8 a = *(const bf16x8*)(sQ + (16 * w + fr) * 136 + ks * 32 + fq * 8);
#pragma unroll
            for (int nt = 0; nt < 4; ++nt) { const bf16x8 bb = *(const bf16x8*)(sKd + (nt * 16 + fr) * 136 + ks * 32 + fq * 8); at[nt] = mfma16(a, bb, at[nt]); }
        }
        __syncthreads();
#pragma unroll
        for (int nt = 0; nt < 4; ++nt)
#pragma unroll
            for (int i = 0; i < 4; ++i) { const int t = 16 * w + fq * 4 + i, s = nt * 16 + fr; sAt[t * 72 + s] = f2bf(s <= t ? at[nt][i] : 0.f); }
        __syncthreads();
        f32x4 oacc[4][2];
#pragma unroll
        for (int mt = 0; mt < 4; ++mt) { oacc[mt][0] = (f32x4){0.f, 0.f, 0.f, 0.f}; oacc[mt][1] = (f32x4){0.f, 0.f, 0.f, 0.f}; }
#pragma unroll
        for (int ks = 0; ks < 2; ++ks) {
            bf16x8 bb[2];
#pragma unroll
            for (int nt = 0; nt < 2; ++nt) bb[nt] = *(const bf16x8*)(sI + (32 * w + nt * 16 + fr) * 72 + ks * 32 + fq * 8);
#pragma unroll
            for (int mt = 0; mt < 4; ++mt) {
                const bf16x8 a = *(const bf16x8*)(sAt + (mt * 16 + fr) * 72 + ks * 32 + fq * 8);
                oacc[mt][0] = mfma16(a, bb[0], oacc[mt][0]); oacc[mt][1] = mfma16(a, bb[1], oacc[mt][1]);
            }
        }
#pragma unroll
        for (int s = 0; s < 4; ++s) {
            const bf16x8 b0 = pack8(st[2 * s][0], st[2 * s + 1][0]), b1 = pack8(st[2 * s][1], st[2 * s + 1][1]);
#pragma unroll
            for (int mt = 0; mt < 4; ++mt) {
                const u16* qa = sQ + (mt * 16 + fr) * 136 + 32 * s + fq * 4;
                const bf16x8 a = mk8(*(const u32x2*)qa, *(const u32x2*)(qa + 16));
                oacc[mt][0] = mfma16(a, b0, oacc[mt][0]); oacc[mt][1] = mfma16(a, b1, oacc[mt][1]);
            }
        }
#pragma unroll
        for (int kt = 0; kt < 8; ++kt) {
            const f32x4 d = *(const f32x4*)(sDec + kt * 16 + fq * 4);
            st[kt][0] = st[kt][0] * d; st[kt][1] = st[kt][1] * d;
        }
#pragma unroll
        for (int ks = 0; ks < 2; ++ks) {
            bf16x8 bb[2];
#pragma unroll
            for (int nt = 0; nt < 2; ++nt) bb[nt] = *(const bf16x8*)(sI + (32 * w + nt * 16 + fr) * 72 + ks * 32 + fq * 8);
#pragma unroll
            for (int kt = 0; kt < 8; ++kt) {
                const bf16x8 a = *(const bf16x8*)(sKt + (kt * 16 + fr) * 72 + ks * 32 + fq * 8);
                st[kt][0] = mfma16(a, bb[0], st[kt][0]); st[kt][1] = mfma16(a, bb[1], st[kt][1]);
            }
        }
#pragma unroll
        for (int mt = 0; mt < 4; ++mt)
#pragma unroll
            for (int i = 0; i < 4; ++i) {
                float q = oacc[mt][0][i] * oacc[mt][0][i] + oacc[mt][1][i] * oacc[mt][1][i];
                q += __shfl_xor(q, 1); q += __shfl_xor(q, 2); q += __shfl_xor(q, 4); q += __shfl_xor(q, 8);
                if (fr == 0) sSsq[w * 64 + mt * 16 + fq * 4 + i] = q;
            }
        __syncthreads();
#pragma unroll
        for (int mt = 0; mt < 4; ++mt)
#pragma unroll
            for (int i = 0; i < 4; ++i) {
                const int t = mt * 16 + fq * 4 + i;
                const float tot = (sSsq[t] + sSsq[64 + t]) + (sSsq[128 + t] + sSsq[192 + t]);
                const float r = rsqrtf(tot * (1.f / 128.f) + LN_EPS);
#pragma unroll
                for (int nt = 0; nt < 2; ++nt) {
                    const int v = 32 * w + nt * 16 + fr;
                    const float gate = bf2f(H[(row_base + t) * 3072 + 2560 + h * 128 + v]);
                    YM[(row_base + t) * 1024 + 512 + h * 128 + v] = f2bf(oacc[mt][nt][i] * r * gn[v] * gate);
                }
            }
    }
}

template <int ROWS, int COLS, int LD>
DI void stage_tile(u16* s, const u16* g, int ld) {
    constexpr int CPR = COLS / 8, TOT = ROWS * CPR;
    const int tid = get_tid();
#pragma unroll
    for (int c0 = 0; c0 < TOT; c0 += 256) { const int c = c0 + tid, r = c / CPR, cc = (c % CPR) * 8; *(u32x4*)(s + r * LD + cc) = *(const u32x4*)(g + (size_t)r * ld + cc); }
}

template <int NDC, class MaskF>
DI void attn_keytile(const u16* Kg, int ldk, const u16* Vtg, int ldv, const bf16x8 (&bq)[NDC * 2], f32x4 (&oacc)[NDC * 4], float& m, float& l,
                     u16* sK, u16* sV, const MaskF& maskf, int fr, int fq) {
    f32x4 sacc[8];
#pragma unroll
    for (int i = 0; i < 8; ++i) sacc[i] = (f32x4){0.f, 0.f, 0.f, 0.f};
#pragma unroll
    for (int dc = 0; dc < NDC; ++dc) {
        __syncthreads();
        stage_tile<128, 64, 72>(sK, Kg + dc * 64, ldk);
        __syncthreads();
#pragma unroll
        for (int ks = 0; ks < 2; ++ks)
#pragma unroll
            for (int mt = 0; mt < 8; ++mt) { const bf16x8 a = *(const bf16x8*)(sK + (mt * 16 + fr) * 72 + ks * 32 + fq * 8); sacc[mt] = mfma16(a, bq[dc * 2 + ks], sacc[mt]); }
    }
    float mx = -1e30f;
#pragma unroll
    for (int mt = 0; mt < 8; ++mt)
#pragma unroll
        for (int i = 0; i < 4; ++i) { const float s = maskf(sacc[mt][i], mt * 16 + fq * 4 + i); sacc[mt][i] = s; mx = fmaxf(mx, s); }
    mx = fmaxf(mx, __shfl_xor(mx, 16)); mx = fmaxf(mx, __shfl_xor(mx, 32));
    const float mnew = fmaxf(m, mx), corr = __expf(m - mnew);
    l *= corr;
#pragma unroll
    for (int i = 0; i < NDC * 4; ++i) oacc[i] = oacc[i] * corr;
    float ps = 0.f;
#pragma unroll
    for (int mt = 0; mt < 8; ++mt)
#pragma unroll
        for (int i = 0; i < 4; ++i) { const float pe = __expf(sacc[mt][i] - mnew); ps += pe; sacc[mt][i] = pe; }
    l += ps; m = mnew;
    bf16x8 pb[4];
#pragma unroll
    for (int s = 0; s < 4; ++s) pb[s] = pack8(sacc[2 * s], sacc[2 * s + 1]);
#pragma unroll
    for (int dc = 0; dc < NDC; ++dc) {
        __syncthreads();
        stage_tile<64, 128, 136>(sV, Vtg + (size_t)dc * 64 * ldv, ldv);
        __syncthreads();
#pragma unroll
        for (int s = 0; s < 4; ++s)
#pragma unroll
            for (int mt = 0; mt < 4; ++mt) {
                const u16* va = sV + (mt * 16 + fr) * 136 + 32 * s + fq * 4;
                const bf16x8 a = mk8(*(const u32x2*)va, *(const u32x2*)(va + 16));
                oacc[dc * 4 + mt] = mfma16(a, pb[s], oacc[dc * 4 + mt]);
            }
    }
}

struct MaskNone { DI float operator()(float s, int) const { return s; } };
struct MaskMoba {
    int key0, tq, qblk; unsigned sel; float slope;
    DI float operator()(float s, int key) const {
        const int tk = key0 + key, j = key0 >> 8;
        const bool ok = (j < qblk) ? ((sel >> j) & 1u) : (tk <= tq);
        return ok ? s - slope * (float)(tq - tk) : -1e30f;
    }
};

DI void cross_item(const Params& p, int l, int item, char* lds) {
    const int tid = get_tid(), lane = tid & 63, w = tid >> 6, fr = lane & 15, fq = lane >> 4;
    const int qt = item & 31, h = (item >> 5) & 3, b = item >> 7;
    const u16* Q = (const u16*)(p.ws + O_H);
    const u16* Kd = (const u16*)(p.ws + O_KVK + l * 4 * MB);
    const u16* Vt = (const u16*)(p.ws + O_KVV + l * 4 * MB);
    u16* O = (u16*)(p.ws + O_YM);
    u16* sK = (u16*)lds; u16* sV = sK + 128 * 72;
    const size_t qrow = (size_t)b * SEQ + qt * 64 + w * 16 + fr;
    bf16x8 bq[8];
#pragma unroll
    for (int i = 0; i < 8; ++i) bq[i] = *(const bf16x8*)(Q + qrow * 1024 + h * 256 + i * 32 + fq * 8);
    f32x4 oacc[16];
#pragma unroll
    for (int i = 0; i < 16; ++i) oacc[i] = (f32x4){0.f, 0.f, 0.f, 0.f};
    float m = -1e30f, lsum = 0.f;
    MaskNone mk;
    for (int kt = 0; kt < 2; ++kt)
        attn_keytile<4>(Kd + ((size_t)b * 256 + kt * 128) * 1024 + h * 256, 1024, Vt + ((size_t)(b * 4 + h) * 256) * 256 + kt * 128, 256, bq, oacc, m, lsum, sK, sV, mk, fr, fq);
    lsum += __shfl_xor(lsum, 16); lsum += __shfl_xor(lsum, 32);
    const float inv = 1.f / lsum;
#pragma unroll
    for (int i = 0; i < 16; ++i) {
        u32x2 o; o.x = pack2(oacc[i][0] * inv, oacc[i][1] * inv); o.y = pack2(oacc[i][2] * inv, oacc[i][3] * inv);
        *(u32x2*)(O + qrow * 1024 + h * 256 + i * 16 + fq * 4) = o;
    }
}

DI void moba_item(const Params& p, int item, char* lds) {
    const int tid = get_tid(), lane = tid & 63, w = tid >> 6, fr = lane & 15, fq = lane >> 4;
    const int qt = 31 - (item >> 7), bh = item & 127, h = bh & 15, b = bh >> 4;
    const u16* Q = (const u16*)(p.ws + O_H);
    const u16* Kd = (const u16*)(p.ws + O_H + 32 * MB);
    const u16* Vt = (const u16*)(p.ws + O_H + 64 * MB);
    const float* KM = (const float*)(p.ws + O_KM);
    u16* O = (u16*)(p.ws + O_YM);
    u16* sK = (u16*)lds; u16* sV = sK + 128 * 72;
    const int q0 = qt * 64, qblk = q0 >> 8, tq = q0 + w * 16 + fr;
    const size_t qrow = (size_t)b * SEQ + tq;
    bf16x8 bq[2];
#pragma unroll
    for (int i = 0; i < 2; ++i) bq[i] = *(const bf16x8*)(Q + qrow * 1024 + h * 64 + i * 32 + fq * 8);
    unsigned sel = 0;
    if (qblk > 0) {
        float aff[8];
#pragma unroll
        for (int j = 0; j < 8; ++j) aff[j] = 0.f;
        const u16* qp = Q + qrow * 1024 + h * 64;
        const float* km = KM + (size_t)bh * 8 * 64;
#pragma unroll
        for (int d8 = 0; d8 < 8; ++d8) {
            const u32x4 qv = *(const u32x4*)(qp + d8 * 8);
            float qf[8];
#pragma unroll
            for (int e = 0; e < 4; ++e) { qf[2 * e] = __uint_as_float(qv[e] << 16); qf[2 * e + 1] = __uint_as_float(qv[e] & 0xffff0000u); }
#pragma unroll
            for (int j = 0; j < 7; ++j)
                if (j < qblk) {
#pragma unroll
                    for (int e = 0; e < 8; ++e) aff[j] += qf[e] * km[j * 64 + d8 * 8 + e];
                }
        }
#pragma unroll
        for (int j = 0; j < 7; ++j) {
            int rank = 0;
#pragma unroll
            for (int j2 = 0; j2 < 7; ++j2) if (j2 < qblk && j2 != j && (aff[j2] > aff[j] || (aff[j2] == aff[j] && j2 < j))) ++rank;
            if (j < qblk && rank < 3) sel |= 1u << j;
        }
    }
    f32x4 oacc[4];
#pragma unroll
    for (int i = 0; i < 4; ++i) oacc[i] = (f32x4){0.f, 0.f, 0.f, 0.f};
    float m = -1e30f, lsum = 0.f;
    MaskMoba mk; mk.tq = tq; mk.qblk = qblk; mk.sel = sel; mk.slope = exp2f(-0.5f * (float)(h + 1));
    for (int kt = q0 >> 7; kt >= 0; --kt) {
        mk.key0 = kt * 128;
        attn_keytile<1>(Kd + ((size_t)b * SEQ + kt * 128) * 1024 + h * 64, 1024, Vt + ((size_t)(b * 16 + h) * 64) * 2048 + kt * 128, 2048, bq, oacc, m, lsum, sK, sV, mk, fr, fq);
    }
    lsum += __shfl_xor(lsum, 16); lsum += __shfl_xor(lsum, 32);
    const float inv = 1.f / lsum;
#pragma unroll
    for (int i = 0; i < 4; ++i) {
        u32x2 o; o.x = pack2(oacc[i][0] * inv, oacc[i][1] * inv); o.y = pack2(oacc[i][2] * inv, oacc[i][3] * inv);
        *(u32x2*)(O + qrow * 1024 + h * 64 + i * 16 + fq * 4) = o;
    }
}

DI void kmean_item(const Params& p, int item, char* lds) {
    const int tid = get_tid(), d = tid & 63, part = tid >> 6;
    const int j = item & 7, bh = item >> 3, h = bh & 15, b = bh >> 4;
    const u16* Kd = (const u16*)(p.ws + O_H + 32 * MB) + ((size_t)b * SEQ + j * 256 + part * 64) * 1024 + h * 64 + d;
    float* red = (float*)lds;
    float s = 0.f;
#pragma unroll 8
    for (int i = 0; i < 64; ++i) s += bf2f(Kd[(size_t)i * 1024]);
    __syncthreads();
    red[part * 64 + d] = s;
    __syncthreads();
    if (part == 0) ((float*)(p.ws + O_KM))[(size_t)item * 64 + d] = ((red[d] + red[64 + d]) + (red[128 + d] + red[192 + d])) * (1.f / 256.f);
}

__global__ void __launch_bounds__(256, 2) mega(Params p) {
    extern __shared__ __attribute__((aligned(16))) char lds[];
    cg::grid_group grid = cg::this_grid();
    char* ws = p.ws;
    volatile LAS unsigned* xst = (volatile LAS unsigned*)(lds + LDS_MAIN);
    if (threadIdx.x == 0) { xst[0] = 0u; xst[1] = 0u; xst[2] = 0u; xst[3] = 0u; }
    __syncthreads();
    const XcdBarrier xb = xcd_barrier_post((unsigned*)(ws + O_BAR), xst);
    u16* XB = (u16*)(ws + O_XB); u16* Hb = (u16*)(ws + O_H); u16* YM = (u16*)(ws + O_YM);
    for (int ph = p.ph0; ph < p.ph1; ++ph) {
        const int l = ph >= 12 ? 1 : 0;
#ifdef DUPMASK
        for (int rep = 0; rep < (((DUPMASK >> ph) & 1u) ? 2 : 1); ++rep)
#endif
        switch (ph) {
        case 0: if (EN(0)) phase_prep(p, lds); break;
        case 1: {
            EpiH0 e0; e0.H = Hb; e0.lbl = p.in[16];
            gemm_phase(XB, 1024, (const u16*)(ws + O_WT_EVIN), 1024, 1024, 128, 24, 8, lds, e0, 0, 0);
            for (int l2 = 0; l2 < 2; ++l2) {
                EpiKV ek; ek.Kd = (u16*)(ws + O_KVK + l2 * 4 * MB); ek.Vt = (u16*)(ws + O_KVV + l2 * 4 * MB);
                gemm_phase((const u16*)(ws + O_MEMB), 1024, (const u16*)(ws + O_WT_WKV + l2 * 4 * MB), 1024, 1024, 16, 16, 2, lds, ek, 0, 3072 + l2 * 256);
            }
        } break;
        case 2: {
            for (int it = blockIdx.x; it < 32 + 512; it += gridDim.x) { if (it < 32) { if (EN(2)) hgrn_item(p, it, lds); } else { if (EN(3)) gmlp_item(p, it - 32, lds); } }
        } break;
        case 3: { EpiZ e; e.res = p.in[0]; e.out = p.out; gemm_phase(YM, 1024, (const u16*)(ws + O_WT_EVOUT), 1024, 1024, 128, 8, 8, lds, e, 0, 0); } break;
        case 4: case 8: case 11: case 16: case 20: case 23: {
            const int k = (ph == 4 || ph == 16) ? 0 : ((ph == 8 || ph == 20) ? 1 : 2);
            phase_ln(p.in[2] + (l * 3 + k) * 1024, p.in[3] + (l * 3 + k) * 1024, p.out, XB);
        } break;
        case 5: case 17: { EpiBf e; e.D = Hb; e.ld = 1024; e.scale = 0.0625f; gemm_phase(XB, 1024, (const u16*)(ws + O_WT_WQ + l * 2 * MB), 1024, 1024, 128, 8, 8, lds, e, 0, 0); } break;
        case 6: case 18: { for (int it = blockIdx.x; it < 1024; it += gridDim.x) if (EN(6)) cross_item(p, l, it, lds); } break;
        case 7: case 19: { EpiZ e; e.res = p.out; e.out = p.out; gemm_phase(YM, 1024, (const u16*)(ws + O_WT_WO + l * 2 * MB), 1024, 1024, 128, 8, 8, lds, e, 0, 0); } break;
        case 9: case 21: { EpiFFN e; e.Hd = Hb; gemm_phase(XB, 1024, (const u16*)(ws + O_WT_FIN + l * 11 * MB), 1024, 1024, 128, 44, 8, lds, e, 0, 0); } break;
        case 10: case 22: { EpiZ e; e.res = p.out; e.out = p.out; gemm_phase(Hb, DFF, (const u16*)(ws + O_WT_FOUT + l * (11 * MB / 2)), DFF, DFF, 128, 8, 8, lds, e, 0, 0); } break;
        case 12: { EpiQKV1 e; e.Q = Hb; e.Kd = (u16*)(ws + O_H + 32 * MB); e.Vt = (u16*)(ws + O_H + 64 * MB); gemm_phase(XB, 1024, (const u16*)(ws + O_WT_QKV), 1024, 1024, 128, 24, 8, lds, e, 0, 0); } break;
        case 13: { for (int it = blockIdx.x; it < 1024; it += gridDim.x) kmean_item(p, it, lds); } break;
        case 14: { for (int it = blockIdx.x; it < 4096; it += gridDim.x) if (EN(14)) moba_item(p, it, lds); } break;
        case 15: { EpiZ e; e.res = p.out; e.out = p.out; gemm_phase(YM, 1024, (const u16*)(ws + O_WT_ODOUT), 1024, 1024, 128, 8, 8, lds, e, 0, 0); } break;
        default: break;
        }
        if (ph + 1 < p.ph1) { if (p.use_cg) grid.sync(); else xcd_barrier(xb); }
    }
}

extern "C" void kernel_launch(void* const* d_in, const int* in_sizes, int n_in, void* d_out, int out_size, void* d_ws, size_t ws_size, hipStream_t stream) {
    static int grid = 0;
    if (grid == 0) {
        if (n_in != 19 || ws_size < WS_END) { fprintf(stderr, "kernel_launch: unexpected n_in %d / ws %zu (need %zu)\n", n_in, ws_size, (size_t)WS_END); grid = -1; return; }
        int dev = 0, cus = 0, per_cu = 0;
        hipGetDevice(&dev);
        hipDeviceGetAttribute(&cus, hipDeviceAttributeMultiprocessorCount, dev);
        if (hipFuncSetAttribute((const void*)mega, hipFuncAttributeMaxDynamicSharedMemorySize, LDS_BYTES) != hipSuccess) { fprintf(stderr, "hipFuncSetAttribute failed\n"); grid = -1; return; }
        if (hipOccupancyMaxActiveBlocksPerMultiprocessor(&per_cu, (const void*)mega, 256, LDS_BYTES) != hipSuccess || per_cu < 1) { fprintf(stderr, "occupancy query failed\n"); grid = -1; return; }
        if (per_cu > 2) per_cu = 2;
        grid = cus * per_cu;
        grid -= grid % 8;
        fprintf(stderr, "kernel_launch: grid %d (cus %d per_cu %d)\n", grid, cus, per_cu);
    }
    if (grid < 0) return;
    Params p{};
    for (int i = 0; i < 19; ++i) p.in[i] = (const float*)d_in[i];
    p.out = (float*)d_out; p.ws = (char*)d_ws;
#if MULTI_LAUNCH
    for (int ph = 0; ph < NPHASE; ++ph) {
        p.ph0 = ph; p.ph1 = ph + 1;
        hipLaunchKernelGGL(mega, dim3(grid), dim3(256), LDS_BYTES, stream, p);
    }
#else
    p.ph0 = 0; p.ph1 = NPHASE; p.use_cg = 0;
    if (hipMemsetAsync((char*)d_ws + O_BAR, 0, XCD_BAR_WORDS * 4, stream) != hipSuccess) { fprintf(stderr, "memset failed\n"); return; }
    void* args[] = {&p};
    hipError_t e = hipLaunchCooperativeKernel((void*)mega, dim3(grid), dim3(256), args, LDS_BYTES, stream);
    if (e != hipSuccess) fprintf(stderr, "cooperative launch failed: %s (grid %d)\n", hipGetErrorString(e), grid);
#endif
}
```

```cpp
#include <hip/hip_runtime.h>
#include <hip/hip_cooperative_groups.h>
#include <cstdio>
#include <cstdint>
namespace cg = cooperative_groups;

#ifndef MULTI_LAUNCH
#define MULTI_LAUNCH 0
#endif

#ifndef PHMASK
#define PHMASK 0xFFFFFFFFu
#endif
#define EN(x) ((PHMASK >> (x)) & 1u)
#define DI __device__ __forceinline__
typedef unsigned short u16;
typedef short bf16x8 __attribute__((ext_vector_type(8)));
typedef float f32x4 __attribute__((ext_vector_type(4)));
typedef unsigned u32x4 __attribute__((ext_vector_type(4)));
typedef unsigned u32x2 __attribute__((ext_vector_type(2)));

constexpr int NT = 16384, DM = 1024, SEQ = 2048;
constexpr int DFF = 2816;
constexpr float ALPHA = 1.41421356237309515f;
constexpr float LN_EPS = 1e-5f;
constexpr int LDS_MAIN = 73728;
constexpr int LDS_BYTES = LDS_MAIN + 16;
constexpr int NPHASE = 26;

constexpr size_t MB = 1u << 20;
constexpr size_t O_WT_EVIN = 0;
constexpr size_t O_WT_EVOUT = O_WT_EVIN + 6 * MB;
constexpr size_t O_WT_WQ = O_WT_EVOUT + 2 * MB;
constexpr size_t O_WT_WKV = O_WT_WQ + 4 * MB;
constexpr size_t O_WT_WO = O_WT_WKV + 8 * MB;
constexpr size_t O_WT_FIN = O_WT_WO + 4 * MB;
constexpr size_t O_WT_FOUT = O_WT_FIN + 22 * MB;
constexpr size_t O_WT_QKV = O_WT_FOUT + 11 * MB;
constexpr size_t O_WT_ODOUT = O_WT_QKV + 6 * MB;
constexpr size_t O_XB = O_WT_ODOUT + 2 * MB;
constexpr size_t O_H = O_XB + 32 * MB;
constexpr size_t O_YM = O_H + 96 * MB;
constexpr size_t O_MEMB = O_YM + 32 * MB;
constexpr size_t O_KVK = O_MEMB + 4 * MB;
constexpr size_t O_KVV = O_KVK + 8 * MB;
constexpr size_t O_KM = O_KVV + 8 * MB;
constexpr size_t O_BAR = O_KM + MB;
constexpr size_t WS_END = O_BAR + MB;

struct Params { const float* in[19]; float* out; char* ws; int ph0, ph1; int use_cg, pad; };

DI int get_tid() { int t = threadIdx.x; asm volatile("" : "+v"(t)); return t; }
DI u16 f2bf(float x) { unsigned u = __float_as_uint(x); u += 0x7fffu + ((u >> 16) & 1u); return (u16)(u >> 16); }
DI float bf2f(u16 h) { return __uint_as_float(((unsigned)h) << 16); }
DI unsigned pack2(float a, float b) { return (unsigned)f2bf(a) | ((unsigned)f2bf(b) << 16); }
DI f32x4 mfma16(bf16x8 a, bf16x8 b, f32x4 c) { return __builtin_amdgcn_mfma_f32_16x16x32_bf16(a, b, c, 0, 0, 0); }
DI bf16x8 mk8(u32x2 lo, u32x2 hi) { u32x4 t; t.x = lo.x; t.y = lo.y; t.z = hi.x; t.w = hi.y; return __builtin_bit_cast(bf16x8, t); }
DI bf16x8 pack8(f32x4 a, f32x4 b) { u32x4 t; t.x = pack2(a[0], a[1]); t.y = pack2(a[2], a[3]); t.z = pack2(b[0], b[1]); t.w = pack2(b[2], b[3]); return __builtin_bit_cast(bf16x8, t); }
DI float gelu_tanh(float x) { float y = 0.7978845608028654f * (x + 0.044715f * x * x * x); float t = 1.f - 2.f / (1.f + __expf(2.f * y)); return 0.5f * x * (1.f + t); }
DI float sigmoidf(float x) { return 1.f / (1.f + __expf(-x)); }
DI float siluf(float x) { return x / (1.f + __expf(-x)); }


#define XB_TMO      128
#define XB_XCNT(j)  (256  + 64 * (j))
#define XB_XSUB(j)  (1280 + 64 * (j))
#define XB_XGEN(j)  (2304 + 64 * (j))
#define XB_TOP      3328
#define XB_TOPGEN   3392
#define XCD_BAR_WORDS 3456
#define XB_SPIN_CAP (1u << 18)
#define LAS __attribute__((address_space(3)))
DI unsigned xb_ld(unsigned* p) { return __hip_atomic_load(p, __ATOMIC_RELAXED, __HIP_MEMORY_SCOPE_AGENT); }
DI unsigned xb_add(unsigned* p, unsigned v) { return __hip_atomic_fetch_add(p, v, __ATOMIC_RELAXED, __HIP_MEMORY_SCOPE_AGENT); }
DI unsigned xb_xcc_id() { return (unsigned)__builtin_amdgcn_s_getreg((3 << 11) | 20) & 0xFu; }
#define XB_SPIN(cond, bar) do { unsigned _sp = 0; while (cond) { __builtin_amdgcn_s_sleep(1); \
    if ((++_sp & 255u) == 0u) { if (xb_ld(&(bar)[XB_TMO])) break; if (_sp > XB_SPIN_CAP) { atomicAdd(&(bar)[XB_TMO], 1u); break; } } } } while (0)
struct XcdBarrier { unsigned* bar; unsigned x; volatile LAS unsigned* st; };
DI XcdBarrier xcd_barrier_post(unsigned* bar, volatile LAS unsigned* st) {
    XcdBarrier b; b.bar = bar; b.x = xb_xcc_id(); b.st = st;
    if (threadIdx.x == 0) (void)xb_add(&bar[XB_XCNT(b.x)], 1u);
    return b;
}
DI void xcd_barrier_complete(unsigned* bar, unsigned x, unsigned& nloc, unsigned& nx) {
    const unsigned G = gridDim.x * gridDim.y * gridDim.z;
    unsigned sum, cnt, mine, sp = 0u;
    for (;;) {
        sum = 0u; cnt = 0u; mine = 0u;
#pragma unroll
        for (unsigned j = 0; j < 16; ++j) { const unsigned c = xb_ld(&bar[XB_XCNT(j)]); sum += c; cnt += (c > 0u) ? 1u : 0u; mine = (j == x) ? c : mine; }
        if (sum == G) break;
        __builtin_amdgcn_s_sleep(1);
        if ((++sp & 255u) == 0u) { if (xb_ld(&bar[XB_TMO])) break; if (sp > XB_SPIN_CAP) { atomicAdd(&bar[XB_TMO], 1u); break; } }
    }
    nloc = mine > 0u ? mine : 1u; nx = cnt > 0u ? cnt : 1u;
}
DI void xcd_barrier(const XcdBarrier& b) {
    asm volatile("s_waitcnt vmcnt(0)" ::: "memory");
    __syncthreads();
    if (threadIdx.x == 0) {
        unsigned* bar = b.bar;
        __builtin_amdgcn_s_waitcnt(0);
        unsigned nloc = b.st[0], nx = b.st[1];
        if (nloc == 0u) { xcd_barrier_complete(bar, b.x, nloc, nx); b.st[0] = nloc; b.st[1] = nx; }
        const unsigned old = xb_add(&bar[XB_XSUB(b.x)], 1u);
        const unsigned gen = old / nloc;
        if (old + 1u == (gen + 1u) * nloc) {
            __builtin_amdgcn_fence(__ATOMIC_RELEASE, "agent");
            asm volatile("s_waitcnt vmcnt(0)" ::: "memory");
            const unsigned og = xb_add(&bar[XB_TOP], 1u);
            const unsigned tg = og / nx;
            if (og + 1u == (tg + 1u) * nx) xb_add(&bar[XB_TOPGEN], 1u);
            else XB_SPIN(xb_ld(&bar[XB_TOPGEN]) == tg, bar);
            __builtin_amdgcn_fence(__ATOMIC_ACQUIRE, "agent");
            xb_add(&bar[XB_XGEN(b.x)], 1u);
            asm volatile("s_waitcnt vmcnt(0)" ::: "memory");
        } else {
            XB_SPIN(xb_ld(&bar[XB_XGEN(b.x)]) == gen, bar);
            __builtin_amdgcn_fence(__ATOMIC_ACQUIRE, "agent");
            asm volatile("s_waitcnt vmcnt(0)" ::: "memory");
        }
    }
    __syncthreads();
}

constexpr int LDT = 72;
DI void tile_map(int t, int nN, int GM, int& pm, int& pn) {
    const int x = t & 7, idx = t >> 3;
    const int per_group = GM * nN, g = idx / per_group, r = idx % per_group;
    pm = x + 8 * (g * GM + (r % GM)); pn = r / GM;
}

template <class Epi>
DI void gemm_tile(const u16* __restrict__ A, int lda, const u16* __restrict__ Bt, int ldb, int K, int row0, int col0, char* lds, const Epi& epi) {
    const int tid = get_tid(), lane = tid & 63, w = tid >> 6, wr = w >> 1, wc = w & 1, fr = lane & 15, fq = lane >> 4;
    u16* sA = (u16*)lds;
    u16* sB = sA + 2 * 128 * LDT;
    const int lr = tid >> 3, lc = (tid & 7) * 8;
    const u16* gA = A + (size_t)(row0 + lr) * lda + lc;
    const u16* gB = Bt + (size_t)(col0 + lr) * ldb + lc;
    u32x4 ra[4], rb[4];
    f32x4 acc[4][4];
#pragma unroll
    for (int i = 0; i < 4; ++i)
#pragma unroll
        for (int j = 0; j < 4; ++j) acc[i][j] = (f32x4){0.f, 0.f, 0.f, 0.f};
    const int nk = K >> 6;
#ifdef GREP
    for (int rep = 0; rep < GREP; ++rep) {
    if (rep) {
#pragma unroll
        for (int i = 0; i < 4; ++i)
#pragma unroll
            for (int j = 0; j < 4; ++j) acc[i][j] = acc[i][j] * 0.f;
    }
#endif
#pragma unroll
    for (int i = 0; i < 4; ++i) { ra[i] = *(const u32x4*)(gA + (size_t)i * 32 * lda); rb[i] = *(const u32x4*)(gB + (size_t)i * 32 * ldb); }
#pragma unroll
    for (int i = 0; i < 4; ++i) { *(u32x4*)(sA + (lr + i * 32) * LDT + lc) = ra[i]; *(u32x4*)(sB + (lr + i * 32) * LDT + lc) = rb[i]; }
    __syncthreads();
    for (int kt = 0; kt < nk; ++kt) {
        const int st = kt & 1;
        if (kt + 1 < nk) {
#pragma unroll
            for (int i = 0; i < 4; ++i) { ra[i] = *(const u32x4*)(gA + (size_t)i * 32 * lda + (kt + 1) * 64); rb[i] = *(const u32x4*)(gB + (size_t)i * 32 * ldb + (kt + 1) * 64); }
        }
        const u16* cA = sA + st * 128 * LDT + (wr * 64 + fr) * LDT + fq * 8;
        const u16* cB = sB + st * 128 * LDT + (wc * 64 + fr) * LDT + fq * 8;
#pragma unroll
        for (int ks = 0; ks < 2; ++ks) {
            bf16x8 a[4], b[4];
#pragma unroll
            for (int i = 0; i < 4; ++i) { a[i] = *(const bf16x8*)(cA + i * 16 * LDT + ks * 32); b[i] = *(const bf16x8*)(cB + i * 16 * LDT + ks * 32); }
#pragma unroll
            for (int i = 0; i < 4; ++i)
#pragma unroll
                for (int j = 0; j < 4; ++j) acc[i][j] = mfma16(a[i], b[j], acc[i][j]);
        }
        if (kt + 1 < nk) {
            const int s2 = st ^ 1;
#pragma unroll
            for (int i = 0; i < 4; ++i) { *(u32x4*)(sA + s2 * 128 * LDT + (lr + i * 32) * LDT + lc) = ra[i]; *(u32x4*)(sB + s2 * 128 * LDT + (lr + i * 32) * LDT + lc) = rb[i]; }
        }
        __syncthreads();
    }
#ifdef GREP
    }
#endif
    epi(acc, row0 + wr * 64, col0 + wc * 64, fr, fq);
}

#define EPI_LOOP _Pragma("unroll") for (int mi = 0; mi < 4; ++mi) _Pragma("unroll") for (int ni = 0; ni < 4; ++ni) _Pragma("unroll") for (int i = 0; i < 4; ++i)

struct EpiH0 {
    u16* H; const float* lbl;
    DI void operator()(const f32x4 (&acc)[4][4], int rb, int cb, int fr, int fq) const {
        const int region = cb >> 9;
        EPI_LOOP {
            const int row = rb + mi * 16 + fq * 4 + i, col = cb + ni * 16 + fr;
            float v = acc[mi][ni][i];
            if (region <= 1) v = gelu_tanh(v);
            else if (region == 3) { const int c = col - 1536; const float lb = 1.f / (1.f + __expf(lbl[512 + c] - lbl[c])); v = __logf(lb + (1.f - lb) * sigmoidf(v)); }
            else if (region >= 4) v = siluf(v);
            H[(size_t)row * 3072 + col] = f2bf(v);
        }
    }
};
struct EpiKV {
    u16* Kd; u16* Vt;
    DI void operator()(const f32x4 (&acc)[4][4], int rb, int cb, int fr, int fq) const {
        if (cb < 1024) {
            EPI_LOOP { const int row = rb + mi * 16 + fq * 4 + i, col = cb + ni * 16 + fr; Kd[(size_t)row * 1024 + col] = f2bf(acc[mi][ni][i]); }
        } else {
#pragma unroll
            for (int mi = 0; mi < 4; ++mi)
#pragma unroll
                for (int ni = 0; ni < 4; ++ni) {
                    const int row = rb + mi * 16 + fq * 4, c = cb - 1024 + ni * 16 + fr, b = row >> 8, m = row & 255, h = c >> 8, d = c & 255;
                    u32x2 o; o.x = pack2(acc[mi][ni][0], acc[mi][ni][1]); o.y = pack2(acc[mi][ni][2], acc[mi][ni][3]);
                    *(u32x2*)(Vt + ((size_t)((b * 4 + h) * 256 + d)) * 256 + m) = o;
                }
        }
    }
};
struct EpiZ {
    const float* res; float* out;
    DI void operator()(const f32x4 (&acc)[4][4], int rb, int cb, int fr, int fq) const {
        EPI_LOOP { const size_t o = (size_t)(rb + mi * 16 + fq * 4 + i) * 1024 + cb + ni * 16 + fr; out[o] = ALPHA * res[o] + acc[mi][ni][i]; }
    }
};
struct EpiBf {
    u16* D; int ld; float scale;
    DI void operator()(const f32x4 (&acc)[4][4], int rb, int cb, int fr, int fq) const {
        EPI_LOOP { D[(size_t)(rb + mi * 16 + fq * 4 + i) * ld + cb + ni * 16 + fr] = f2bf(acc[mi][ni][i] * scale); }
    }
};
struct EpiFFN {
    u16* Hd;
    DI void operator()(const f32x4 (&acc)[4][4], int rb, int cb, int fr, int fq) const {
        const int grp = cb >> 6;
#pragma unroll
        for (int mi = 0; mi < 4; ++mi)
#pragma unroll
            for (int ni = 0; ni < 2; ++ni)
#pragma unroll
                for (int i = 0; i < 4; ++i) {
                    const float g = acc[mi][ni][i], u = acc[mi][ni + 2][i];
                    Hd[(size_t)(rb + mi * 16 + fq * 4 + i) * DFF + grp * 32 + ni * 16 + fr] = f2bf(siluf(g) * u);
                }
    }
};
struct EpiQKV1 {
    u16* Q; u16* Kd; u16* Vt;
    DI void operator()(const f32x4 (&acc)[4][4], int rb, int cb, int fr, int fq) const {
        if (cb < 1024) {
            EPI_LOOP { Q[(size_t)(rb + mi * 16 + fq * 4 + i) * 1024 + cb + ni * 16 + fr] = f2bf(acc[mi][ni][i] * 0.125f); }
        } else if (cb < 2048) {
            EPI_LOOP { Kd[(size_t)(rb + mi * 16 + fq * 4 + i) * 1024 + cb - 1024 + ni * 16 + fr] = f2bf(acc[mi][ni][i]); }
        } else {
#pragma unroll
            for (int mi = 0; mi < 4; ++mi)
#pragma unroll
                for (int ni = 0; ni < 4; ++ni) {
                    const int row = rb + mi * 16 + fq * 4, c = cb - 2048 + ni * 16 + fr, b = row >> 11, t = row & 2047, h = c >> 6, d = c & 63;
                    u32x2 o; o.x = pack2(acc[mi][ni][0], acc[mi][ni][1]); o.y = pack2(acc[mi][ni][2], acc[mi][ni][3]);
                    *(u32x2*)(Vt + ((size_t)((b * 16 + h) * 64 + d)) * 2048 + t) = o;
                }
        }
    }
};

template <class Epi>
DI void gemm_phase(const u16* A, int lda, const u16* Bt, int ldb, int K, int nM, int nN, int GM, char* lds, const Epi& epi, int t_begin, int t_total_before) {
    (void)t_begin;
    const int ntile = nM * nN;
    for (int t = blockIdx.x; t < t_total_before + ntile; t += gridDim.x) {
        if (t < t_total_before) continue;
        int pm, pn; tile_map(t - t_total_before, nN, GM, pm, pn);
        gemm_tile(A, lda, Bt, ldb, K, pm * 128, pn * 128, lds, epi);
    }
}

DI void transpose_item(const float* __restrict__ W, int K, int N, u16* __restrict__ WT, int perm, int item, float* scr) {
    const int ntn = N >> 6, kb = item / ntn, nb = item % ntn, k0 = kb * 64, n0 = nb * 64, tid = get_tid();
    __syncthreads();
#pragma unroll
    for (int i = 0; i < 16; ++i) { const int kk = i * 4 + (tid >> 6), nn = tid & 63; scr[kk * 65 + nn] = W[(size_t)(k0 + kk) * N + n0 + nn]; }
    __syncthreads();
    const int n = tid >> 2, c = tid & 3;
    const float* s = scr + (c * 16) * 65 + n;
    u32x4 o0, o1;
    o0.x = pack2(s[0 * 65], s[1 * 65]); o0.y = pack2(s[2 * 65], s[3 * 65]); o0.z = pack2(s[4 * 65], s[5 * 65]); o0.w = pack2(s[6 * 65], s[7 * 65]);
    o1.x = pack2(s[8 * 65], s[9 * 65]); o1.y = pack2(s[10 * 65], s[11 * 65]); o1.z = pack2(s[12 * 65], s[13 * 65]); o1.w = pack2(s[14 * 65], s[15 * 65]);
    int nsrc = n0 + n, drow = nsrc;
    if (perm) { if (nsrc < DFF) drow = (nsrc >> 5) * 64 + (nsrc & 31); else { const int n2 = nsrc - DFF; drow = (n2 >> 5) * 64 + 32 + (n2 & 31); } }
    u32x4* dst = (u32x4*)(WT + (size_t)drow * K + k0 + c * 16);
    dst[0] = o0; dst[1] = o1;
}

DI void phase_prep(const Params& p, char* lds) {
    float* scr = (float*)lds;
    char* ws = p.ws;
    constexpr int T1 = 16 * 48, TS = 16 * 16, TKV = 16 * 32, TFI = 16 * 88, TFO = 44 * 16;
    constexpr int NTR = T1 + TS + 2 * TS + 2 * TKV + 2 * TS + 2 * TFI + 2 * TFO + T1 + TS;
    constexpr int NXC = NT * DM / 2048, NMC = 2048 * DM / 2048;
    for (int it = blockIdx.x; it < NTR + NXC + NMC; it += gridDim.x) {
        int r = it;
        if (r < NTR) {
            if (r < T1) { transpose_item(p.in[9], 1024, 3072, (u16*)(ws + O_WT_EVIN), 0, r, scr); continue; } r -= T1;
            if (r < TS) { transpose_item(p.in[10], 1024, 1024, (u16*)(ws + O_WT_EVOUT), 0, r, scr); continue; } r -= TS;
            if (r < 2 * TS) { const int l = r / TS; transpose_item(p.in[4] + (size_t)l * 1024 * 1024, 1024, 1024, (u16*)(ws + O_WT_WQ + l * 2 * MB), 0, r % TS, scr); continue; } r -= 2 * TS;
            if (r < 2 * TKV) { const int l = r / TKV; transpose_item(p.in[5] + (size_t)l * 1024 * 2048, 1024, 2048, (u16*)(ws + O_WT_WKV + l * 4 * MB), 0, r % TKV, scr); continue; } r -= 2 * TKV;
            if (r < 2 * TS) { const int l = r / TS; transpose_item(p.in[6] + (size_t)l * 1024 * 1024, 1024, 1024, (u16*)(ws + O_WT_WO + l * 2 * MB), 0, r % TS, scr); continue; } r -= 2 * TS;
            if (r < 2 * TFI) { const int l = r / TFI; transpose_item(p.in[7] + (size_t)l * 1024 * 5632, 1024, 5632, (u16*)(ws + O_WT_FIN + l * 11 * MB), 1, r % TFI, scr); continue; } r -= 2 * TFI;
            if (r < 2 * TFO) { const int l = r / TFO; transpose_item(p.in[8] + (size_t)l * 2816 * 1024, 2816, 1024, (u16*)(ws + O_WT_FOUT + l * (11 * MB / 2)), 0, r % TFO, scr); continue; } r -= 2 * TFO;
            if (r < T1) { transpose_item(p.in[17], 1024, 3072, (u16*)(ws + O_WT_QKV), 0, r, scr); continue; } r -= T1;
            transpose_item(p.in[18], 1024, 1024, (u16*)(ws + O_WT_ODOUT), 0, r, scr);
            continue;
        }
        r -= NTR;
        const float* src; u16* dst;
        if (r < NXC) { src = p.in[0]; dst = (u16*)(ws + O_XB); } else { r -= NXC; src = p.in[1]; dst = (u16*)(ws + O_MEMB); }
        const size_t e = (size_t)r * 2048 + get_tid() * 8;
        const f32x4 a = *(const f32x4*)(src + e), b = *(const f32x4*)(src + e + 4);
        u32x4 o; o.x = pack2(a[0], a[1]); o.y = pack2(a[2], a[3]); o.z = pack2(b[0], b[1]); o.w = pack2(b[2], b[3]);
        *(u32x4*)(dst + e) = o;
    }
}

DI void phase_ln(const float* __restrict__ g, const float* __restrict__ bta, float* xio, u16* xb) {
    const int tid = get_tid(), lane = tid & 63, gw = blockIdx.x * 4 + (tid >> 6), nw = gridDim.x * 4;
    for (int row = gw; row < NT; row += nw) {
        f32x4* xr = (f32x4*)(xio + (size_t)row * 1024);
        f32x4 v[4]; float s = 0.f;
#pragma unroll
        for (int j = 0; j < 4; ++j) { v[j] = xr[lane + 64 * j]; s += (v[j][0] + v[j][1]) + (v[j][2] + v[j][3]); }
#pragma unroll
        for (int o = 1; o < 64; o <<= 1) s += __shfl_xor(s, o);
        const float mean = s * (1.f / 1024.f); float q = 0.f;
#pragma unroll
        for (int j = 0; j < 4; ++j) { v[j] = v[j] - mean; q += (v[j][0] * v[j][0] + v[j][1] * v[j][1]) + (v[j][2] * v[j][2] + v[j][3] * v[j][3]); }
#pragma unroll
        for (int o = 1; o < 64; o <<= 1) q += __shfl_xor(q, o);
        const float rstd = rsqrtf(q * (1.f / 1024.f) + LN_EPS);
#pragma unroll
        for (int j = 0; j < 4; ++j) {
            const f32x4 gg = ((const f32x4*)g)[lane + 64 * j], bb = ((const f32x4*)bta)[lane + 64 * j];
            const f32x4 y = v[j] * rstd * gg + bb;
            xr[lane + 64 * j] = y;
            u32x2 o; o.x = pack2(y[0], y[1]); o.y = pack2(y[2], y[3]);
            ((u32x2*)(xb + (size_t)row * 1024))[lane + 64 * j] = o;
        }
    }
}

DI void gmlp_item(const Params& p, int item, char* lds) {
    const int tid = get_tid(), lane = tid & 63, w = tid >> 6, wr = w >> 1, wc = w & 1, fr = lane & 15, fq = lane >> 4;
    const int g = item & 3, n = (item >> 2) & 15, b = item >> 6;
    const u16* H = (const u16*)(p.ws + O_H);
    u16* YM = (u16*)(p.ws + O_YM);
    u16* sW = (u16*)lds; u16* sV = sW + 128 * 136;
    const size_t row_base = (size_t)b * SEQ + n * 128;
    __syncthreads();
    {
        const float* Wg = p.in[11] + (size_t)g * 128 * 128;
#pragma unroll 4
        for (int c = tid; c < 128 * 32; c += 256) {
            const int t = c >> 5, s4 = (c & 31) * 4;
            const f32x4 v = *(const f32x4*)(Wg + t * 128 + s4);
            u32x2 o; o.x = pack2(s4 + 0 <= t ? v[0] : 0.f, s4 + 1 <= t ? v[1] : 0.f); o.y = pack2(s4 + 2 <= t ? v[2] : 0.f, s4 + 3 <= t ? v[3] : 0.f);
            *(u32x2*)(sW + t * 136 + s4) = o;
        }
    }
    {
        const int r = tid >> 1, half = tid & 1;
        const u16* src = H + (row_base + r) * 3072 + 512 + g * 128 + half * 64;
        float x[64]; float s = 0.f;
#pragma unroll
        for (int j = 0; j < 8; ++j) {
            const u32x4 q = *(const u32x4*)(src + j * 8);
#pragma unroll
            for (int e = 0; e < 4; ++e) { x[j * 8 + 2 * e] = __uint_as_float(q[e] << 16); x[j * 8 + 2 * e + 1] = __uint_as_float(q[e] & 0xffff0000u); }
        }
#pragma unroll
        for (int j = 0; j < 64; ++j) s += x[j];
        s += __shfl_xor(s, 1);
        const float mean = s * (1.f / 128.f); float q2 = 0.f;
#pragma unroll
        for (int j = 0; j < 64; ++j) { x[j] -= mean; q2 += x[j] * x[j]; }
        q2 += __shfl_xor(q2, 1);
        const float rstd = rsqrtf(q2 * (1.f / 128.f) + LN_EPS);
        const float* lg = p.in[13] + g * 128 + half * 64; const float* lb = p.in[14] + g * 128 + half * 64;
#pragma unroll
        for (int j = 0; j < 64; ++j) sV[(half * 64 + j) * 136 + r] = f2bf(x[j] * rstd * lg[j] + lb[j]);
    }
    __syncthreads();
    f32x4 acc[4][4];
#pragma unroll
    for (int i = 0; i < 4; ++i)
#pragma unroll
        for (int j = 0; j < 4; ++j) acc[i][j] = (f32x4){0.f, 0.f, 0.f, 0.f};
    const u16* cA = sW + (wr * 64 + fr) * 136 + fq * 8;
    const u16* cB = sV + (wc * 64 + fr) * 136 + fq * 8;
#pragma unroll
    for (int ks = 0; ks < 4; ++ks) {
        bf16x8 a[4], bb[4];
#pragma unroll
        for (int i = 0; i < 4; ++i) { a[i] = *(const bf16x8*)(cA + i * 16 * 136 + ks * 32); bb[i] = *(const bf16x8*)(cB + i * 16 * 136 + ks * 32); }
#pragma unroll
        for (int i = 0; i < 4; ++i)
#pragma unroll
            for (int j = 0; j < 4; ++j) acc[i][j] = mfma16(a[i], bb[j], acc[i][j]);
    }
    const float* bs = p.in[12] + g * 128;
#pragma unroll
    for (int mi = 0; mi < 4; ++mi)
#pragma unroll
        for (int i = 0; i < 4; ++i) {
            const int t = wr * 64 + mi * 16 + fq * 4 + i; const float bt = bs[t];
#pragma unroll
            for (int ni = 0; ni < 4; ++ni) {
                const int c = wc * 64 + ni * 16 + fr;
                const float u = bf2f(H[(row_base + t) * 3072 + g * 128 + c]);
                YM[(row_base + t) * 1024 + g * 128 + c] = f2bf(u * (acc[mi][ni][i] + bt));
            }
        }
}

template <int ROWS, int COLS, int LD>
DI void stage_tile(u16* s, const u16* g, int ld) {
    constexpr int CPR = COLS / 8, TOT = ROWS * CPR;
    const int tid = get_tid();
#pragma unroll
    for (int c0 = 0; c0 < TOT; c0 += 256) { const int c = c0 + tid, r = c / CPR, cc = (c % CPR) * 8; *(u32x4*)(s + r * LD + cc) = *(const u32x4*)(g + (size_t)r * ld + cc); }
}

DI void hgrn_prep_cum(const u16* src, int th, int ch, float* sTot, float (&cum)[32], float& total) {
    float run = 0.f;
#pragma unroll
    for (int j = 0; j < 32; ++j) { run += bf2f(src[(size_t)j * 3072 + 1536]); cum[j] = run; }
    sTot[th * 128 + ch] = run;
    __syncthreads();
    const float t0 = sTot[ch], t1 = sTot[128 + ch], off = th ? t0 : 0.f;
    total = t0 + t1;
#pragma unroll
    for (int j = 0; j < 32; ++j) cum[j] += off;
}

DI void hgrnA_item(const Params& p, int item, char* lds) {
    const int tid = get_tid(), lane = tid & 63, w = tid >> 6, fr = lane & 15, fq = lane >> 4;
    const int n = item & 31, bh = item >> 5, h = bh & 3, b = bh >> 2;
    const u16* H = (const u16*)(p.ws + O_H);
    u16* YM = (u16*)(p.ws + O_YM);
    float* U = p.out + (size_t)item * 16384;
    float* DEC = (float*)(p.ws + O_KM + 512 * 1024) + (size_t)item * 128;
    u16* sQ = (u16*)lds;
    u16* sKd = sQ + 64 * 136;
    u16* sKt = sKd + 64 * 136;
    u16* sI = sKt + 128 * 72;
    float* sTot = (float*)(sI + 128 * 72);
    u16* sAt = sKd;
    const int ch = tid & 127, th = tid >> 7;
    const size_t row_base = (size_t)b * SEQ + n * 64;
    __syncthreads();
    {
        const u16* src = H + (row_base + th * 32) * 3072 + h * 128 + ch;
        float cum[32]; float total;
        hgrn_prep_cum(src, th, ch, sTot, cum, total);
        if (th == 0) DEC[ch] = __expf(total);
        float prev = th ? sTot[ch] : 0.f;
#pragma unroll
        for (int j8 = 0; j8 < 4; ++j8) {
            unsigned kt[4], iv[4];
#pragma unroll
            for (int jj = 0; jj < 8; ++jj) {
                const int j = j8 * 8 + jj;
                const float c = cum[j], lf = c - prev; prev = c;
                const float q = bf2f(src[(size_t)j * 3072 + 1024]);
                const unsigned ivv = src[(size_t)j * 3072 + 2048];
                const float kc = 1.f - __expf(lf);
                sQ[(th * 32 + j) * 136 + ch] = f2bf(q * __expf(c));
                sKd[(th * 32 + j) * 136 + ch] = f2bf(kc * __expf(-c));
                const unsigned ktv = f2bf(kc * __expf(total - c));
                if (jj & 1) { kt[jj >> 1] |= ktv << 16; iv[jj >> 1] |= ivv << 16; } else { kt[jj >> 1] = ktv; iv[jj >> 1] = ivv; }
            }
            *(u32x4*)(sKt + ch * 72 + th * 32 + j8 * 8) = (u32x4){kt[0], kt[1], kt[2], kt[3]};
            *(u32x4*)(sI + ch * 72 + th * 32 + j8 * 8) = (u32x4){iv[0], iv[1], iv[2], iv[3]};
        }
    }
    __syncthreads();
    f32x4 at[4];
#pragma unroll
    for (int nt = 0; nt < 4; ++nt) at[nt] = (f32x4){0.f, 0.f, 0.f, 0.f};
#pragma unroll
    for (int ks = 0; ks < 4; ++ks) {
        const bf16x8 a = *(const bf16x8*)(sQ + (16 * w + fr) * 136 + ks * 32 + fq * 8);
#pragma unroll
        for (int nt = 0; nt < 4; ++nt) { const bf16x8 bb = *(const bf16x8*)(sKd + (nt * 16 + fr) * 136 + ks * 32 + fq * 8); at[nt] = mfma16(a, bb, at[nt]); }
    }
    __syncthreads();
#pragma unroll
    for (int nt = 0; nt < 4; ++nt)
#pragma unroll
        for (int i = 0; i < 4; ++i) { const int t = 16 * w + fq * 4 + i, s = nt * 16 + fr; sAt[t * 72 + s] = f2bf(s <= t ? at[nt][i] : 0.f); }
    __syncthreads();
    {
        f32x4 oacc[4][2];
#pragma unroll
        for (int mt = 0; mt < 4; ++mt) { oacc[mt][0] = (f32x4){0.f, 0.f, 0.f, 0.f}; oacc[mt][1] = (f32x4){0.f, 0.f, 0.f, 0.f}; }
#pragma unroll
        for (int ks = 0; ks < 2; ++ks) {
            bf16x8 bb[2];
#pragma unroll
            for (int nt = 0; nt < 2; ++nt) bb[nt] = *(const bf16x8*)(sI + (32 * w + nt * 16 + fr) * 72 + ks * 32 + fq * 8);
#pragma unroll
            for (int mt = 0; mt < 4; ++mt) {
                const bf16x8 a = *(const bf16x8*)(sAt + (mt * 16 + fr) * 72 + ks * 32 + fq * 8);
                oacc[mt][0] = mfma16(a, bb[0], oacc[mt][0]); oacc[mt][1] = mfma16(a, bb[1], oacc[mt][1]);
            }
        }
#pragma unroll
        for (int mt = 0; mt < 4; ++mt)
#pragma unroll
            for (int nt = 0; nt < 2; ++nt)
#pragma unroll
                for (int i = 0; i < 4; ++i)
                    YM[(row_base + mt * 16 + fq * 4 + i) * 1024 + 512 + h * 128 + 32 * w + nt * 16 + fr] = f2bf(oacc[mt][nt][i]);
    }
    {
        f32x4 u[2][8];
#pragma unroll
        for (int mt = 0; mt < 2; ++mt)
#pragma unroll
            for (int nt = 0; nt < 8; ++nt) u[mt][nt] = (f32x4){0.f, 0.f, 0.f, 0.f};
#pragma unroll
        for (int ks = 0; ks < 2; ++ks) {
            bf16x8 a[2];
#pragma unroll
            for (int mt = 0; mt < 2; ++mt) a[mt] = *(const bf16x8*)(sI + (32 * w + mt * 16 + fr) * 72 + ks * 32 + fq * 8);
#pragma unroll
            for (int nt = 0; nt < 8; ++nt) {
                const bf16x8 bb = *(const bf16x8*)(sKt + (nt * 16 + fr) * 72 + ks * 32 + fq * 8);
                u[0][nt] = mfma16(a[0], bb, u[0][nt]); u[1][nt] = mfma16(a[1], bb, u[1][nt]);
            }
        }
#pragma unroll
        for (int mt = 0; mt < 2; ++mt)
#pragma unroll
            for (int nt = 0; nt < 8; ++nt)
#pragma unroll
                for (int i = 0; i < 4; ++i) U[(32 * w + mt * 16 + fq * 4 + i) * 128 + nt * 16 + fr] = u[mt][nt][i];
    }
}

DI void hgrn_scan(const Params& p) {
    const int tid = get_tid();
    const float* U = p.out;
    const float* DEC = (const float*)(p.ws + O_KM + 512 * 1024);
    u16* ST = (u16*)(p.ws + O_XB);
    for (int idx = blockIdx.x * 256 + tid; idx < 32 * 4096; idx += gridDim.x * 256) {
        const int bh = idx >> 12, e4 = (idx & 4095) * 4, k = e4 & 127;
        f32x4 s = (f32x4){0.f, 0.f, 0.f, 0.f};
#pragma unroll 8
        for (int n = 0; n < 32; ++n) {
            const size_t item = (size_t)bh * 32 + n;
            const f32x4 u = *(const f32x4*)(U + item * 16384 + e4);
            const f32x4 d = *(const f32x4*)(DEC + item * 128 + k);
            u32x2 o; o.x = pack2(s[0], s[1]); o.y = pack2(s[2], s[3]);
            *(u32x2*)(ST + item * 16384 + e4) = o;
            s = d * s + u;
        }
    }
}

DI void hgrnC_item(const Params& p, int item, char* lds) {
    const int tid = get_tid(), lane = tid & 63, w = tid >> 6, fr = lane & 15, fq = lane >> 4;
    const int n = item & 31, bh = item >> 5, h = bh & 3, b = bh >> 2;
    const u16* H = (const u16*)(p.ws + O_H);
    u16* YM = (u16*)(p.ws + O_YM);
    const u16* ST = (const u16*)(p.ws + O_XB) + (size_t)item * 16384;
    u16* sQ = (u16*)lds;
    u16* sS = sQ + 64 * 136;
    float* sTot = (float*)(sS + 128 * 136);
    float* sSsq = sTot + 256;
    const float* gn = p.in[15] + h * 128;
    const int ch = tid & 127, th = tid >> 7;
    const size_t row_base = (size_t)b * SEQ + n * 64;
    __syncthreads();
    stage_tile<128, 128, 136>(sS, ST, 128);
    {
        const u16* src = H + (row_base + th * 32) * 3072 + h * 128 + ch;
        float cum[32]; float total;
        hgrn_prep_cum(src, th, ch, sTot, cum, total);
#pragma unroll
        for (int j = 0; j < 32; ++j) sQ[(th * 32 + j) * 136 + ch] = f2bf(bf2f(src[(size_t)j * 3072 + 1024]) * __expf(cum[j]));
    }
    __syncthreads();
    f32x4 oacc[4][2];
#pragma unroll
    for (int mt = 0; mt < 4; ++mt) { oacc[mt][0] = (f32x4){0.f, 0.f, 0.f, 0.f}; oacc[mt][1] = (f32x4){0.f, 0.f, 0.f, 0.f}; }
#pragma unroll
    for (int ks = 0; ks < 4; ++ks) {
        bf16x8 bb[2];
#pragma unroll
        for (int nt = 0; nt < 2; ++nt) bb[nt] = *(const bf16x8*)(sS + (32 * w + nt * 16 + fr) * 136 + ks * 32 + fq * 8);
#pragma unroll
        for (int mt = 0; mt < 4; ++mt) {
            const bf16x8 a = *(const bf16x8*)(sQ + (mt * 16 + fr) * 136 + ks * 32 + fq * 8);
            oacc[mt][0] = mfma16(a, bb[0], oacc[mt][0]); oacc[mt][1] = mfma16(a, bb[1], oacc[mt][1]);
        }
    }
#pragma unroll
    for (int mt = 0; mt < 4; ++mt)
#pragma unroll
        for (int i = 0; i < 4; ++i) {
#pragma unroll
            for (int nt = 0; nt < 2; ++nt) oacc[mt][nt][i] += bf2f(YM[(row_base + mt * 16 + fq * 4 + i) * 1024 + 512 + h * 128 + 32 * w + nt * 16 + fr]);
            float q = oacc[mt][0][i] * oacc[mt][0][i] + oacc[mt][1][i] * oacc[mt][1][i];
            q += __shfl_xor(q, 1); q += __shfl_xor(q, 2); q += __shfl_xor(q, 4); q += __shfl_xor(q, 8);
            if (fr == 0) sSsq[w * 64 + mt * 16 + fq * 4 + i] = q;
        }
    __syncthreads();
#pragma unroll
    for (int mt = 0; mt < 4; ++mt)
#pragma unroll
        for (int i = 0; i < 4; ++i) {
            const int t = mt * 16 + fq * 4 + i;
            const float tot = (sSsq[t] + sSsq[64 + t]) + (sSsq[128 + t] + sSsq[192 + t]);
            const float r = rsqrtf(tot * (1.f / 128.f) + LN_EPS);
#pragma unroll
            for (int nt = 0; nt < 2; ++nt) {
                const int v = 32 * w + nt * 16 + fr;
                const float gate = bf2f(H[(row_base + t) * 3072 + 2560 + h * 128 + v]);
                YM[(row_base + t) * 1024 + 512 + h * 128 + v] = f2bf(oacc[mt][nt][i] * r * gn[v] * gate);
            }
        }
}

template <int NDC, class MaskF>
DI void attn_keytile(const u16* Kg, int ldk, const u16* Vtg, int ldv, const bf16x8 (&bq)[NDC * 2], f32x4 (&oacc)[NDC * 4], float& m, float& l,
                     u16* sK, u16* sV, const MaskF& maskf, int fr, int fq) {
    f32x4 sacc[8];
#pragma unroll
    for (int i = 0; i < 8; ++i) sacc[i] = (f32x4){0.f, 0.f, 0.f, 0.f};
#pragma unroll
    for (int dc = 0; dc < NDC; ++dc) {
        __syncthreads();
        stage_tile<128, 64, 72>(sK, Kg + dc * 64, ldk);
        __syncthreads();
#pragma unroll
        for (int ks = 0; ks < 2; ++ks)
#pragma unroll
            for (int mt = 0; mt < 8; ++mt) { const bf16x8 a = *(const bf16x8*)(sK + (mt * 16 + fr) * 72 + ks * 32 + fq * 8); sacc[mt] = mfma16(a, bq[dc * 2 + ks], sacc[mt]); }
    }
    float mx = -1e30f;
#pragma unroll
    for (int mt = 0; mt < 8; ++mt)
#pragma unroll
        for (int i = 0; i < 4; ++i) { const float s = maskf(sacc[mt][i], mt * 16 + fq * 4 + i); sacc[mt][i] = s; mx = fmaxf(mx, s); }
    mx = fmaxf(mx, __shfl_xor(mx, 16)); mx = fmaxf(mx, __shfl_xor(mx, 32));
    const float mnew = fmaxf(m, mx), corr = __expf(m - mnew);
    l *= corr;
#pragma unroll
    for (int i = 0; i < NDC * 4; ++i) oacc[i] = oacc[i] * corr;
    float ps = 0.f;
#pragma unroll
    for (int mt = 0; mt < 8; ++mt)
#pragma unroll
        for (int i = 0; i < 4; ++i) { const float pe = __expf(sacc[mt][i] - mnew); ps += pe; sacc[mt][i] = pe; }
    l += ps; m = mnew;
    bf16x8 pb[4];
#pragma unroll
    for (int s = 0; s < 4; ++s) pb[s] = pack8(sacc[2 * s], sacc[2 * s + 1]);
#pragma unroll
    for (int dc = 0; dc < NDC; ++dc) {
        __syncthreads();
        stage_tile<64, 128, 136>(sV, Vtg + (size_t)dc * 64 * ldv, ldv);
        __syncthreads();
#pragma unroll
        for (int s = 0; s < 4; ++s)
#pragma unroll
            for (int mt = 0; mt < 4; ++mt) {
                const u16* va = sV + (mt * 16 + fr) * 136 + 32 * s + fq * 4;
                const bf16x8 a = mk8(*(const u32x2*)va, *(const u32x2*)(va + 16));
                oacc[dc * 4 + mt] = mfma16(a, pb[s], oacc[dc * 4 + mt]);
            }
    }
}

struct MaskNone { DI float operator()(float s, int) const { return s; } };
struct MaskMoba {
    int key0, tq, qblk; unsigned sel; float slope;
    DI float operator()(float s, int key) const {
        const int tk = key0 + key, j = key0 >> 8;
        const bool ok = (j < qblk) ? ((sel >> j) & 1u) : (tk <= tq);
        return ok ? s - slope * (float)(tq - tk) : -1e30f;
    }
};

DI void cross_item(const Params& p, int l, int item, char* lds) {
    const int tid = get_tid(), lane = tid & 63, w = tid >> 6, fr = lane & 15, fq = lane >> 4;
    const int qt = item & 31, h = (item >> 5) & 3, b = item >> 7;
    const u16* Q = (const u16*)(p.ws + O_H);
    const u16* Kd = (const u16*)(p.ws + O_KVK + l * 4 * MB);
    const u16* Vt = (const u16*)(p.ws + O_KVV + l * 4 * MB);
    u16* O = (u16*)(p.ws + O_YM);
    u16* sK = (u16*)lds; u16* sV = sK + 128 * 72;
    const size_t qrow = (size_t)b * SEQ + qt * 64 + w * 16 + fr;
    bf16x8 bq[8];
#pragma unroll
    for (int i = 0; i < 8; ++i) bq[i] = *(const bf16x8*)(Q + qrow * 1024 + h * 256 + i * 32 + fq * 8);
    f32x4 oacc[16];
#pragma unroll
    for (int i = 0; i < 16; ++i) oacc[i] = (f32x4){0.f, 0.f, 0.f, 0.f};
    float m = -1e30f, lsum = 0.f;
    MaskNone mk;
    for (int kt = 0; kt < 2; ++kt)
        attn_keytile<4>(Kd + ((size_t)b * 256 + kt * 128) * 1024 + h * 256, 1024, Vt + ((size_t)(b * 4 + h) * 256) * 256 + kt * 128, 256, bq, oacc, m, lsum, sK, sV, mk, fr, fq);
    lsum += __shfl_xor(lsum, 16); lsum += __shfl_xor(lsum, 32);
    const float inv = 1.f / lsum;
#pragma unroll
    for (int i = 0; i < 16; ++i) {
        u32x2 o; o.x = pack2(oacc[i][0] * inv, oacc[i][1] * inv); o.y = pack2(oacc[i][2] * inv, oacc[i][3] * inv);
        *(u32x2*)(O + qrow * 1024 + h * 256 + i * 16 + fq * 4) = o;
    }
}

DI void moba_item(const Params& p, int item, char* lds) {
    const int tid = get_tid(), lane = tid & 63, w = tid >> 6, fr = lane & 15, fq = lane >> 4;
    const int qt = 31 - (item >> 7), bh = item & 127, h = bh & 15, b = bh >> 4;
    const u16* Q = (const u16*)(p.ws + O_H);
    const u16* Kd = (const u16*)(p.ws + O_H + 32 * MB);
    const u16* Vt = (const u16*)(p.ws + O_H + 64 * MB);
    const float* KM = (const float*)(p.ws + O_KM);
    u16* O = (u16*)(p.ws + O_YM);
    u16* sK = (u16*)lds; u16* sV = sK + 128 * 72;
    const int q0 = qt * 64, qblk = q0 >> 8, tq = q0 + w * 16 + fr;
    const size_t qrow = (size_t)b * SEQ + tq;
    bf16x8 bq[2];
#pragma unroll
    for (int i = 0; i < 2; ++i) bq[i] = *(const bf16x8*)(Q + qrow * 1024 + h * 64 + i * 32 + fq * 8);
    unsigned sel = 0;
    if (qblk > 0) {
        float aff[8];
#pragma unroll
        for (int j = 0; j < 8; ++j) aff[j] = 0.f;
        const u16* qp = Q + qrow * 1024 + h * 64;
        const float* km = KM + (size_t)bh * 8 * 64;
#pragma unroll
        for (int d8 = 0; d8 < 8; ++d8) {
            const u32x4 qv = *(const u32x4*)(qp + d8 * 8);
            float qf[8];
#pragma unroll
            for (int e = 0; e < 4; ++e) { qf[2 * e] = __uint_as_float(qv[e] << 16); qf[2 * e + 1] = __uint_as_float(qv[e] & 0xffff0000u); }
#pragma unroll
            for (int j = 0; j < 7; ++j)
                if (j < qblk) {
#pragma unroll
                    for (int e = 0; e < 8; ++e) aff[j] += qf[e] * km[j * 64 + d8 * 8 + e];
                }
        }
#pragma unroll
        for (int j = 0; j < 7; ++j) {
            int rank = 0;
#pragma unroll
            for (int j2 = 0; j2 < 7; ++j2) if (j2 < qblk && j2 != j && (aff[j2] > aff[j] || (aff[j2] == aff[j] && j2 < j))) ++rank;
            if (j < qblk && rank < 3) sel |= 1u << j;
        }
    }
    f32x4 oacc[4];
#pragma unroll
    for (int i = 0; i < 4; ++i) oacc[i] = (f32x4){0.f, 0.f, 0.f, 0.f};
    float m = -1e30f, lsum = 0.f;
    MaskMoba mk; mk.tq = tq; mk.qblk = qblk; mk.sel = sel; mk.slope = exp2f(-0.5f * (float)(h + 1));
    for (int kt = q0 >> 7; kt >= 0; --kt) {
        mk.key0 = kt * 128;
        attn_keytile<1>(Kd + ((size_t)b * SEQ + kt * 128) * 1024 + h * 64, 1024, Vt + ((size_t)(b * 16 + h) * 64) * 2048 + kt * 128, 2048, bq, oacc, m, lsum, sK, sV, mk, fr, fq);
    }
    lsum += __shfl_xor(lsum, 16); lsum += __shfl_xor(lsum, 32);
    const float inv = 1.f / lsum;
#pragma unroll
    for (int i = 0; i < 4; ++i) {
        u32x2 o; o.x = pack2(oacc[i][0] * inv, oacc[i][1] * inv); o.y = pack2(oacc[i][2] * inv, oacc[i][3] * inv);
        *(u32x2*)(O + qrow * 1024 + h * 64 + i * 16 + fq * 4) = o;
    }
}

DI void kmean_item(const Params& p, int item, char* lds) {
    const int tid = get_tid(), d = tid & 63, part = tid >> 6;
    const int j = item & 7, bh = item >> 3, h = bh & 15, b = bh >> 4;
    const u16* Kd = (const u16*)(p.ws + O_H + 32 * MB) + ((size_t)b * SEQ + j * 256 + part * 64) * 1024 + h * 64 + d;
    float* red = (float*)lds;
    float s = 0.f;
#pragma unroll 8
    for (int i = 0; i < 64; ++i) s += bf2f(Kd[(size_t)i * 1024]);
    __syncthreads();
    red[part * 64 + d] = s;
    __syncthreads();
    if (part == 0) ((float*)(p.ws + O_KM))[(size_t)item * 64 + d] = ((red[d] + red[64 + d]) + (red[128 + d] + red[192 + d])) * (1.f / 256.f);
}

__global__ void __launch_bounds__(256, 2) mega(Params p) {
    extern __shared__ __attribute__((aligned(16))) char lds[];
    cg::grid_group grid = cg::this_grid();
    char* ws = p.ws;
    volatile LAS unsigned* xst = (volatile LAS unsigned*)(lds + LDS_MAIN);
    if (threadIdx.x == 0) { xst[0] = 0u; xst[1] = 0u; xst[2] = 0u; xst[3] = 0u; }
    __syncthreads();
    const XcdBarrier xb = xcd_barrier_post((unsigned*)(ws + O_BAR), xst);
    u16* XB = (u16*)(ws + O_XB); u16* Hb = (u16*)(ws + O_H); u16* YM = (u16*)(ws + O_YM);
    for (int pi = p.ph0; pi < p.ph1; ++pi) {
        const int ph = pi < 3 ? pi : (pi < 5 ? 21 + pi : pi - 2);
        const int l = (ph >= 12 && ph < 24) ? 1 : 0;
#ifdef DUPMASK
        for (int rep = 0; rep < (((DUPMASK >> ph) & 1u) ? 2 : 1); ++rep)
#endif
        switch (ph) {
        case 0: if (EN(0)) phase_prep(p, lds); break;
        case 1: {
            EpiH0 e0; e0.H = Hb; e0.lbl = p.in[16];
            gemm_phase(XB, 1024, (const u16*)(ws + O_WT_EVIN), 1024, 1024, 128, 24, 8, lds, e0, 0, 0);
            for (int l2 = 0; l2 < 2; ++l2) {
                EpiKV ek; ek.Kd = (u16*)(ws + O_KVK + l2 * 4 * MB); ek.Vt = (u16*)(ws + O_KVV + l2 * 4 * MB);
                gemm_phase((const u16*)(ws + O_MEMB), 1024, (const u16*)(ws + O_WT_WKV + l2 * 4 * MB), 1024, 1024, 16, 16, 2, lds, ek, 0, 3072 + l2 * 256);
            }
        } break;
        case 2: { for (int it = blockIdx.x; it < 1024 + 512; it += gridDim.x) { if (it < 1024) hgrnA_item(p, it, lds); else gmlp_item(p, it - 1024, lds); } } break;
        case 24: hgrn_scan(p); break;
        case 25: { for (int it = blockIdx.x; it < 1024; it += gridDim.x) hgrnC_item(p, it, lds); } break;
        case 3: { EpiZ e; e.res = p.in[0]; e.out = p.out; gemm_phase(YM, 1024, (const u16*)(ws + O_WT_EVOUT), 1024, 1024, 128, 8, 8, lds, e, 0, 0); } break;
        case 4: case 8: case 11: case 16: case 20: case 23: {
            const int k = (ph == 4 || ph == 16) ? 0 : ((ph == 8 || ph == 20) ? 1 : 2);
            phase_ln(p.in[2] + (l * 3 + k) * 1024, p.in[3] + (l * 3 + k) * 1024, p.out, XB);
        } break;
        case 5: case 17: { EpiBf e; e.D = Hb; e.ld = 1024; e.scale = 0.0625f; gemm_phase(XB, 1024, (const u16*)(ws + O_WT_WQ + l * 2 * MB), 1024, 1024, 128, 8, 8, lds, e, 0, 0); } break;
        case 6: case 18: { for (int it = blockIdx.x; it < 1024; it += gridDim.x) if (EN(6)) cross_item(p, l, it, lds); } break;
        case 7: case 19: { EpiZ e; e.res = p.out; e.out = p.out; gemm_phase(YM, 1024, (const u16*)(ws + O_WT_WO + l * 2 * MB), 1024, 1024, 128, 8, 8, lds, e, 0, 0); } break;
        case 9: case 21: { EpiFFN e; e.Hd = Hb; gemm_phase(XB, 1024, (const u16*)(ws + O_WT_FIN + l * 11 * MB), 1024, 1024, 128, 44, 8, lds, e, 0, 0); } break;
        case 10: case 22: { EpiZ e; e.res = p.out; e.out = p.out; gemm_phase(Hb, DFF, (const u16*)(ws + O_WT_FOUT + l * (11 * MB / 2)), DFF, DFF, 128, 8, 8, lds, e, 0, 0); } break;
        case 12: { EpiQKV1 e; e.Q = Hb; e.Kd = (u16*)(ws + O_H + 32 * MB); e.Vt = (u16*)(ws + O_H + 64 * MB); gemm_phase(XB, 1024, (const u16*)(ws + O_WT_QKV), 1024, 1024, 128, 24, 8, lds, e, 0, 0); } break;
        case 13: { for (int it = blockIdx.x; it < 1024; it += gridDim.x) kmean_item(p, it, lds); } break;
        case 14: { for (int it = blockIdx.x; it < 4096; it += gridDim.x) if (EN(14)) moba_item(p, it, lds); } break;
        case 15: { EpiZ e; e.res = p.out; e.out = p.out; gemm_phase(YM, 1024, (const u16*)(ws + O_WT_ODOUT), 1024, 1024, 128, 8, 8, lds, e, 0, 0); } break;
        default: break;
        }
        if (pi + 1 < p.ph1) { if (p.use_cg) grid.sync(); else xcd_barrier(xb); }
    }
}

extern "C" void kernel_launch(void* const* d_in, const int* in_sizes, int n_in, void* d_out, int out_size, void* d_ws, size_t ws_size, hipStream_t stream) {
    static int grid = 0;
    if (grid == 0) {
        if (n_in != 19 || ws_size < WS_END) { fprintf(stderr, "kernel_launch: unexpected n_in %d / ws %zu (need %zu)\n", n_in, ws_size, (size_t)WS_END); grid = -1; return; }
        int dev = 0, cus = 0, per_cu = 0;
        hipGetDevice(&dev);
        hipDeviceGetAttribute(&cus, hipDeviceAttributeMultiprocessorCount, dev);
        if (hipFuncSetAttribute((const void*)mega, hipFuncAttributeMaxDynamicSharedMemorySize, LDS_BYTES) != hipSuccess) { fprintf(stderr, "hipFuncSetAttribute failed\n"); grid = -1; return; }
        if (hipOccupancyMaxActiveBlocksPerMultiprocessor(&per_cu, (const void*)mega, 256, LDS_BYTES) != hipSuccess || per_cu < 1) { fprintf(stderr, "occupancy query failed\n"); grid = -1; return; }
        if (per_cu > 2) per_cu = 2;
        grid = cus * per_cu;
        grid -= grid % 8;
        fprintf(stderr, "kernel_launch: grid %d (cus %d per_cu %d)\n", grid, cus, per_cu);
    }
    if (grid < 0) return;
    Params p{};
    for (int i = 0; i < 19; ++i) p.in[i] = (const float*)d_in[i];
    p.out = (float*)d_out; p.ws = (char*)d_ws;
#if MULTI_LAUNCH
    for (int ph = 0; ph < NPHASE; ++ph) {
        p.ph0 = ph; p.ph1 = ph + 1;
        hipLaunchKernelGGL(mega, dim3(grid), dim3(256), LDS_BYTES, stream, p);
    }
#else
    p.ph0 = 0; p.ph1 = NPHASE; p.use_cg = 0;
    if (hipMemsetAsync((char*)d_ws + O_BAR, 0, XCD_BAR_WORDS * 4, stream) != hipSuccess) { fprintf(stderr, "memset failed\n"); return; }
    void* args[] = {&p};
    hipError_t e = hipLaunchCooperativeKernel((void*)mega, dim3(grid), dim3(256), args, LDS_BYTES, stream);
    if (e != hipSuccess) fprintf(stderr, "cooperative launch failed: %s (grid %d)\n", hipGetErrorString(e), grid);
#endif
}
```

```cpp
#include <hip/hip_runtime.h>
#include <hip/hip_cooperative_groups.h>
#include <cstdio>
#include <cstdint>
namespace cg = cooperative_groups;

#ifndef MULTI_LAUNCH
#define MULTI_LAUNCH 0
#endif

#ifndef PHMASK
#define PHMASK 0xFFFFFFFFu
#endif
#define EN(x) ((PHMASK >> (x)) & 1u)
#define DI __device__ __forceinline__
typedef unsigned short u16;
typedef short bf16x8 __attribute__((ext_vector_type(8)));
typedef float f32x4 __attribute__((ext_vector_type(4)));
typedef unsigned u32x4 __attribute__((ext_vector_type(4)));
typedef unsigned u32x2 __attribute__((ext_vector_type(2)));

constexpr int NT = 16384, DM = 1024, SEQ = 2048;
constexpr int DFF = 2816;
constexpr float ALPHA = 1.41421356237309515f;
constexpr float LN_EPS = 1e-5f;
constexpr int LDS_MAIN = 73728;
constexpr int LDS_BYTES = 2 * LDS_MAIN + 16;
constexpr int NPHASE = 26;

constexpr size_t MB = 1u << 20;
constexpr size_t O_WT_EVIN = 0;
constexpr size_t O_WT_EVOUT = O_WT_EVIN + 6 * MB;
constexpr size_t O_WT_WQ = O_WT_EVOUT + 2 * MB;
constexpr size_t O_WT_WKV = O_WT_WQ + 4 * MB;
constexpr size_t O_WT_WO = O_WT_WKV + 8 * MB;
constexpr size_t O_WT_FIN = O_WT_WO + 4 * MB;
constexpr size_t O_WT_FOUT = O_WT_FIN + 22 * MB;
constexpr size_t O_WT_QKV = O_WT_FOUT + 11 * MB;
constexpr size_t O_WT_ODOUT = O_WT_QKV + 6 * MB;
constexpr size_t O_XB = O_WT_ODOUT + 2 * MB;
constexpr size_t O_H = O_XB + 32 * MB;
constexpr size_t O_YM = O_H + 96 * MB;
constexpr size_t O_MEMB = O_YM + 32 * MB;
constexpr size_t O_KVK = O_MEMB + 4 * MB;
constexpr size_t O_KVV = O_KVK + 8 * MB;
constexpr size_t O_KM = O_KVV + 8 * MB;
constexpr size_t O_BAR = O_KM + MB;
constexpr size_t O_VRAW = O_BAR + MB;
constexpr size_t WS_END = O_VRAW + 8 * MB;

struct Params { const float* in[19]; float* out; char* ws; int ph0, ph1; int use_cg, pad; };

DI int get_tid8() { int t = threadIdx.x; asm volatile("" : "+v"(t)); return t; }
DI int get_tid() { int t = threadIdx.x & 255; asm volatile("" : "+v"(t)); return t; }
DI u16 f2bf(float x) { unsigned u = __float_as_uint(x); u += 0x7fffu + ((u >> 16) & 1u); return (u16)(u >> 16); }
DI float bf2f(u16 h) { return __uint_as_float(((unsigned)h) << 16); }
DI unsigned pack2(float a, float b) { return (unsigned)f2bf(a) | ((unsigned)f2bf(b) << 16); }
DI f32x4 mfma16(bf16x8 a, bf16x8 b, f32x4 c) { return __builtin_amdgcn_mfma_f32_16x16x32_bf16(a, b, c, 0, 0, 0); }
DI bf16x8 mk8(u32x2 lo, u32x2 hi) { u32x4 t; t.x = lo.x; t.y = lo.y; t.z = hi.x; t.w = hi.y; return __builtin_bit_cast(bf16x8, t); }
DI bf16x8 pack8(f32x4 a, f32x4 b) { u32x4 t; t.x = pack2(a[0], a[1]); t.y = pack2(a[2], a[3]); t.z = pack2(b[0], b[1]); t.w = pack2(b[2], b[3]); return __builtin_bit_cast(bf16x8, t); }
DI float gelu_tanh(float x) { float y = 0.7978845608028654f * (x + 0.044715f * x * x * x); float t = 1.f - 2.f / (1.f + __expf(2.f * y)); return 0.5f * x * (1.f + t); }
DI float sigmoidf(float x) { return 1.f / (1.f + __expf(-x)); }
DI float siluf(float x) { return x / (1.f + __expf(-x)); }


#define XB_TMO      128
#define XB_XCNT(j)  (256  + 64 * (j))
#define XB_XSUB(j)  (1280 + 64 * (j))
#define XB_XGEN(j)  (2304 + 64 * (j))
#define XB_TOP      3328
#define XB_TOPGEN   3392
#define XCD_BAR_WORDS 3456
#define XB_SPIN_CAP (1u << 18)
#define LAS __attribute__((address_space(3)))
DI unsigned xb_ld(unsigned* p) { return __hip_atomic_load(p, __ATOMIC_RELAXED, __HIP_MEMORY_SCOPE_AGENT); }
DI unsigned xb_add(unsigned* p, unsigned v) { return __hip_atomic_fetch_add(p, v, __ATOMIC_RELAXED, __HIP_MEMORY_SCOPE_AGENT); }
DI unsigned xb_xcc_id() { return (unsigned)__builtin_amdgcn_s_getreg((3 << 11) | 20) & 0xFu; }
#define XB_SPIN(cond, bar) do { unsigned _sp = 0; while (cond) { __builtin_amdgcn_s_sleep(1); \
    if ((++_sp & 255u) == 0u) { if (xb_ld(&(bar)[XB_TMO])) break; if (_sp > XB_SPIN_CAP) { atomicAdd(&(bar)[XB_TMO], 1u); break; } } } } while (0)
struct XcdBarrier { unsigned* bar; unsigned x; volatile LAS unsigned* st; };
DI XcdBarrier xcd_barrier_post(unsigned* bar, volatile LAS unsigned* st) {
    XcdBarrier b; b.bar = bar; b.x = xb_xcc_id(); b.st = st;
    if (threadIdx.x == 0) (void)xb_add(&bar[XB_XCNT(b.x)], 1u);
    return b;
}
DI void xcd_barrier_complete(unsigned* bar, unsigned x, unsigned& nloc, unsigned& nx) {
    const unsigned G = gridDim.x * gridDim.y * gridDim.z;
    unsigned sum, cnt, mine, sp = 0u;
    for (;;) {
        sum = 0u; cnt = 0u; mine = 0u;
#pragma unroll
        for (unsigned j = 0; j < 16; ++j) { const unsigned c = xb_ld(&bar[XB_XCNT(j)]); sum += c; cnt += (c > 0u) ? 1u : 0u; mine = (j == x) ? c : mine; }
        if (sum == G) break;
        __builtin_amdgcn_s_sleep(1);
        if ((++sp & 255u) == 0u) { if (xb_ld(&bar[XB_TMO])) break; if (sp > XB_SPIN_CAP) { atomicAdd(&bar[XB_TMO], 1u); break; } }
    }
    nloc = mine > 0u ? mine : 1u; nx = cnt > 0u ? cnt : 1u;
}
DI void xcd_barrier(const XcdBarrier& b) {
    asm volatile("s_waitcnt vmcnt(0)" ::: "memory");
    __syncthreads();
    if (threadIdx.x == 0) {
        unsigned* bar = b.bar;
        __builtin_amdgcn_s_waitcnt(0);
        unsigned nloc = b.st[0], nx = b.st[1];
        if (nloc == 0u) { xcd_barrier_complete(bar, b.x, nloc, nx); b.st[0] = nloc; b.st[1] = nx; }
        const unsigned old = xb_add(&bar[XB_XSUB(b.x)], 1u);
        const unsigned gen = old / nloc;
        if (old + 1u == (gen + 1u) * nloc) {
            __builtin_amdgcn_fence(__ATOMIC_RELEASE, "agent");
            asm volatile("s_waitcnt vmcnt(0)" ::: "memory");
            const unsigned og = xb_add(&bar[XB_TOP], 1u);
            const unsigned tg = og / nx;
            if (og + 1u == (tg + 1u) * nx) xb_add(&bar[XB_TOPGEN], 1u);
            else XB_SPIN(xb_ld(&bar[XB_TOPGEN]) == tg, bar);
            __builtin_amdgcn_fence(__ATOMIC_ACQUIRE, "agent");
            xb_add(&bar[XB_XGEN(b.x)], 1u);
            asm volatile("s_waitcnt vmcnt(0)" ::: "memory");
        } else {
            XB_SPIN(xb_ld(&bar[XB_XGEN(b.x)]) == gen, bar);
            __builtin_amdgcn_fence(__ATOMIC_ACQUIRE, "agent");
            asm volatile("s_waitcnt vmcnt(0)" ::: "memory");
        }
    }
    __syncthreads();
}

namespace pg8 {
#define PG8_LAS __attribute__((address_space(3)))
typedef unsigned short bf16_t;
typedef short bf16x8 __attribute__((ext_vector_type(8)));
typedef float f32x4 __attribute__((ext_vector_type(4)));
typedef unsigned u32x4 __attribute__((ext_vector_type(4)));
constexpr int BM = 256, BK = 64, HALF = 128, HTB = HALF * BK * 2  , STAGE_BYTES = 8 * HTB, NXCD = 8, WGM = 8;

__host__ __device__ __forceinline__ int lds_byte(int r, int c) { const int st = (r >> 4) * 2 + (c >> 5), rr = r & 15, cc = c & 31, ob = rr * 64 + cc * 2; return st * 1024 + (ob ^ (((ob >> 9) & 1) << 5)); }
__host__ __device__ __forceinline__ void stage_rc(int b, int& R, int& C) { const int st = b / 1024, sb = b % 1024, swz = sb ^ (((sb >> 9) & 1) << 5); R = (st >> 1) * 16 + swz / 64; C = (st & 1) * 32 + (swz % 64) / 2; }
__host__ __device__ __forceinline__ int perm32(int rho) { const int n = rho >> 4, i = rho & 15; return 8 * (i >> 2) + 4 * n + (i & 3); }

struct Unit { int pm, pn; };
struct Gemm { const bf16_t* A; const bf16_t* Bt; int M, N, K; };

struct StaticOrder {
    int nM, nN, nwg, G, c;
    __host__ __device__ void init(int M, int N, int G_, int c_) { nM = M / BM; nN = N / BM; nwg = nM * nN; G = G_; c = c_; }
    __host__ __device__ bool next(int i, Unit& u) const {
        const long L = (long)i * G + c; if (L >= nwg) return false;
        int wgid = (int)L; { const int q = nwg / NXCD, r = nwg % NXCD, xcd = wgid % NXCD, off = wgid / NXCD; wgid = (xcd < r ? xcd * (q + 1) : r * (q + 1) + (xcd - r) * q) + off; }
        const int nig = WGM * nN, gid = wgid / nig, fm = gid * WGM, gsz = (nM - fm) < WGM ? (nM - fm) : WGM;
        u.pm = fm + ((wgid % nig) % gsz); u.pn = (wgid % nig) / gsz; return true;
    }
    __device__ __forceinline__ void a_ready(const Unit&) const {}
    __device__ __forceinline__ void done(const Unit&) const {}
};

template <class Epi, class Sched, bool ALIGN_EPI = false, bool SP2 = false>
__device__ __forceinline__ void gemm_phase(PG8_LAS unsigned char* lds, const Gemm g, const Sched& S, const Epi& E) {
    int tid_ = threadIdx.x; asm volatile("" : "+v"(tid_)); const int tid = tid_, wid = __builtin_amdgcn_readfirstlane(tid >> 6), lane = tid & 63, wr = wid >> 2, wc = wid & 3, fr = lane & 15, fq = lane >> 4;
    const int K = g.K, nt = K / BK;
    unsigned voffA[2], voffB[2];
#pragma unroll
    for (int i = 0; i < 2; ++i) { int R, C; stage_rc(tid * 16 + i * 8192, R, C); const int Rb = Epi::PERM ? ((R & ~31) + perm32(R & 31)) : R;
        voffA[i] = (unsigned)(R * K + C) * 2u; voffB[i] = (unsigned)(Rb * K + C) * 2u; }
    const size_t kstep = (size_t)(BK * 2);
    const size_t hstep = (size_t)HALF * K * 2;
    const size_t tstep = 2 * hstep;
    const unsigned ldsw = (unsigned)wid * 1024u;
    const int aoff = lds_byte(wr * 64 + fr, fq * 8), boff = lds_byte(wc * 32 + fr, fq * 8);
#define PG8_SA(b, h) (((b) * 2 + (h)) * HTB)
#define PG8_SB(b, h) ((4 + (b) * 2 + (h)) * HTB)
#define PG8_STAGE(bufoff, gbase, voff) do { _Pragma("unroll") for (int _i = 0; _i < 2; ++_i) \
        __builtin_amdgcn_global_load_lds((const unsigned*)((const char*)(gbase) + (voff)[_i]), (PG8_LAS unsigned*)(lds + (bufoff) + ldsw + _i * 8192), 16, 0, 0); } while (0)
#define PG8_LDA(dst, b, h) do { _Pragma("unroll") for (int m = 0; m < 4; ++m) _Pragma("unroll") for (int k = 0; k < 2; ++k) dst[m][k] = *(const PG8_LAS bf16x8*)(lds + PG8_SA(b, h) + aoff + m * 2048 + k * 1024); } while (0)
#define PG8_LDB(dst, b, h) do { _Pragma("unroll") for (int n = 0; n < 2; ++n) _Pragma("unroll") for (int k = 0; k < 2; ++k) dst[n][k] = *(const PG8_LAS bf16x8*)(lds + PG8_SB(b, h) + boff + n * 2048 + k * 1024); } while (0)
#define PG8_MMA(ai, bj, At, Bt) do { __builtin_amdgcn_s_setprio(1); _Pragma("unroll") for (int m = 0; m < 4; ++m) _Pragma("unroll") for (int n = 0; n < 2; ++n) _Pragma("unroll") for (int k = 0; k < 2; ++k) \
        acc[ai][bj][m][n] = __builtin_amdgcn_mfma_f32_16x16x32_bf16(Bt[n][k], At[m][k], acc[ai][bj][m][n], 0, 0, 0); __builtin_amdgcn_s_setprio(0); } while (0)
#define PG8_WAIT_V(n) asm volatile("s_waitcnt vmcnt(" #n ")" ::: "memory")
#define PG8_WAIT_L(n) asm volatile("s_waitcnt lgkmcnt(" #n ")" ::: "memory")
#define PG8_BAR __builtin_amdgcn_s_barrier()
#define PG8_SCHED __builtin_amdgcn_sched_barrier(0)
    Unit cur, nxt; int ui = 0;
    if (!S.next(0, cur)) return;
    f32x4 acc[2][2][4][2];
#pragma unroll
    for (int a = 0; a < 2; ++a)
#pragma unroll
        for (int b = 0; b < 2; ++b)
#pragma unroll
            for (int m = 0; m < 4; ++m)
#pragma unroll
                for (int n = 0; n < 2; ++n) acc[a][b][m][n] = (f32x4){0.f, 0.f, 0.f, 0.f};
    bf16x8 At[4][2], B0[2][2], B1[2][2];
    const char* cA = (const char*)g.A + (size_t)cur.pm * tstep; const char* cB = (const char*)g.Bt + (size_t)cur.pn * tstep;
    S.a_ready(cur);
    if constexpr (SP2) {
        PG8_STAGE(PG8_SB(0, 0), cB, voffB); PG8_STAGE(PG8_SB(0, 1), cB + hstep, voffB); PG8_STAGE(PG8_SA(0, 0), cA, voffA); PG8_STAGE(PG8_SA(0, 1), cA + hstep, voffA);
        if (wr == 1) PG8_BAR;
        PG8_WAIT_V(2); PG8_BAR;
        PG8_STAGE(PG8_SB(1, 0), cB + kstep, voffB); PG8_STAGE(PG8_SA(1, 0), cA + kstep, voffA); PG8_STAGE(PG8_SB(1, 1), cB + hstep + kstep, voffB);
        PG8_WAIT_V(6); PG8_BAR;
    } else {
        PG8_STAGE(PG8_SB(0, 0), cB, voffB); PG8_STAGE(PG8_SA(0, 0), cA, voffA); PG8_STAGE(PG8_SB(0, 1), cB + hstep, voffB); PG8_STAGE(PG8_SA(0, 1), cA + hstep, voffA);
        if (wr == 1) PG8_BAR;
        PG8_WAIT_V(4); PG8_BAR;
        PG8_STAGE(PG8_SB(1, 0), cB + kstep, voffB); PG8_STAGE(PG8_SA(1, 0), cA + kstep, voffA); PG8_STAGE(PG8_SB(1, 1), cB + hstep + kstep, voffB);
        PG8_WAIT_V(6); PG8_BAR;
    }
    for (;;) {
        const bool has_next = S.next(ui + 1, nxt);
        const char* nA = has_next ? (const char*)g.A + (size_t)nxt.pm * tstep : cA; const char* nB = has_next ? (const char*)g.Bt + (size_t)nxt.pn * tstep : cB;
        for (int t = 0; t < nt; t += 2) {
            const bool last = (t == nt - 2);
            const char* a1 = cA + (size_t)(t + 1) * kstep;
            const char* a2 = last ? nA : cA + (size_t)(t + 2) * kstep; const char* b2 = last ? nB : cB + (size_t)(t + 2) * kstep;
            const char* a3 = a2 + kstep; const char* b3 = b2 + kstep;
            if (last && has_next) S.a_ready(nxt);
            if constexpr (SP2) {
            PG8_LDB(B0, 0, 0); PG8_LDB(B1, 0, 1); PG8_SCHED; PG8_LDA(At, 0, 0); PG8_STAGE(PG8_SA(1, 1), a1 + hstep, voffA);
            PG8_WAIT_V(8); PG8_WAIT_L(0); PG8_BAR; PG8_MMA(0, 0, At, B0); PG8_MMA(0, 1, At, B1); PG8_BAR; PG8_SCHED;
            PG8_LDA(At, 0, 1); PG8_STAGE(PG8_SB(0, 0), b2, voffB); PG8_STAGE(PG8_SB(0, 1), b2 + hstep, voffB); PG8_STAGE(PG8_SA(0, 0), a2, voffA);
            PG8_WAIT_V(8); PG8_WAIT_L(0); PG8_BAR; PG8_MMA(1, 0, At, B0); PG8_MMA(1, 1, At, B1); PG8_BAR; PG8_SCHED;
            PG8_LDB(B0, 1, 0); PG8_LDB(B1, 1, 1); PG8_SCHED; PG8_LDA(At, 1, 0); PG8_STAGE(PG8_SA(0, 1), a2 + hstep, voffA);
            PG8_WAIT_V(8); PG8_WAIT_L(0); PG8_BAR; PG8_MMA(0, 0, At, B0); PG8_MMA(0, 1, At, B1); PG8_BAR; PG8_SCHED;
            PG8_LDA(At, 1, 1); PG8_STAGE(PG8_SB(1, 0), b3, voffB); PG8_STAGE(PG8_SB(1, 1), b3 + hstep, voffB); PG8_STAGE(PG8_SA(1, 0), a3, voffA);
            PG8_WAIT_V(8); PG8_WAIT_L(0); PG8_BAR; PG8_MMA(1, 0, At, B0); PG8_MMA(1, 1, At, B1); PG8_BAR; PG8_SCHED;
            } else {
            PG8_LDB(B0, 0, 0); PG8_SCHED; PG8_LDA(At, 0, 0); PG8_STAGE(PG8_SA(1, 1), a1 + hstep, voffA);
            PG8_WAIT_L(8); PG8_BAR; PG8_WAIT_L(0); PG8_MMA(0, 0, At, B0); PG8_BAR; PG8_SCHED;
            PG8_LDB(B1, 0, 1); PG8_STAGE(PG8_SB(0, 0), b2, voffB);
            PG8_BAR; PG8_WAIT_L(0); PG8_MMA(0, 1, At, B1); PG8_BAR;
            PG8_LDA(At, 0, 1); PG8_STAGE(PG8_SA(0, 0), a2, voffA);
            PG8_BAR; PG8_WAIT_L(0); PG8_MMA(1, 0, At, B0); PG8_BAR; PG8_SCHED;
            PG8_STAGE(PG8_SB(0, 1), b2 + hstep, voffB);
            PG8_WAIT_V(6); PG8_BAR; PG8_MMA(1, 1, At, B1); PG8_BAR;
            PG8_LDB(B0, 1, 0); PG8_SCHED; PG8_LDA(At, 1, 0); PG8_STAGE(PG8_SA(0, 1), a2 + hstep, voffA);
            PG8_WAIT_L(8); PG8_BAR; PG8_WAIT_L(0); PG8_MMA(0, 0, At, B0); PG8_BAR; PG8_SCHED;
            PG8_LDB(B1, 1, 1); PG8_STAGE(PG8_SB(1, 0), b3, voffB);
            PG8_BAR; PG8_WAIT_L(0); PG8_MMA(0, 1, At, B1); PG8_BAR;
            PG8_LDA(At, 1, 1); PG8_STAGE(PG8_SA(1, 0), a3, voffA);
            PG8_BAR; PG8_WAIT_L(0); PG8_MMA(1, 0, At, B0); PG8_BAR; PG8_SCHED;
            PG8_STAGE(PG8_SB(1, 1), b3 + hstep, voffB);
            PG8_WAIT_V(6); PG8_BAR; PG8_MMA(1, 1, At, B1); PG8_BAR;
            }
        }
        if constexpr (ALIGN_EPI) { if (wr == 0) PG8_BAR; }
        if constexpr (!Epi::AFTER_DRAIN) { E(acc, cur, wr, wc, fr, fq); S.done(cur); }
        if (!has_next) break;
#pragma unroll
        for (int a = 0; a < 2; ++a)
#pragma unroll
            for (int b = 0; b < 2; ++b)
#pragma unroll
                for (int m = 0; m < 4; ++m)
#pragma unroll
                    for (int n = 0; n < 2; ++n) acc[a][b][m][n] = (f32x4){0.f, 0.f, 0.f, 0.f};
        cur = nxt; cA = nA; cB = nB; ++ui;
        if constexpr (ALIGN_EPI) { if (wr == 1) PG8_BAR; }
    }
    PG8_WAIT_V(0);
    if constexpr (!ALIGN_EPI) { if (wr == 0) PG8_BAR; }
    PG8_BAR;
    if constexpr (Epi::AFTER_DRAIN) { E.fused(acc, cur, wr, wc, fr, fq, lds, wid, lane); S.done(cur); }
#undef PG8_SA
#undef PG8_SB
#undef PG8_STAGE
#undef PG8_LDA
#undef PG8_LDB
#undef PG8_MMA
#undef PG8_WAIT_V
#undef PG8_WAIT_L
#undef PG8_BAR
#undef PG8_SCHED
}
}

typedef pg8::Unit Unit;
#define EPI8 _Pragma("unroll") for (int ai = 0; ai < 2; ++ai) _Pragma("unroll") for (int m = 0; m < 4; ++m) _Pragma("unroll") for (int bj = 0; bj < 2; ++bj)
#define EROW (u.pm * 256 + ai * 128 + wr * 64 + m * 16 + fr)
#define ECOL (u.pn * 256 + bj * 128 + wc * 32 + 8 * fq)
DI u32x4 pk8(f32x4 a, f32x4 b) { u32x4 o; o.x = pack2(a[0], a[1]); o.y = pack2(a[2], a[3]); o.z = pack2(b[0], b[1]); o.w = pack2(b[2], b[3]); return o; }

#define EOFF(ld) ((unsigned)EROW * (unsigned)(ld) + (unsigned)ECOL)
#define ESB __builtin_amdgcn_sched_barrier(0)
struct EpiH0 {
    static constexpr bool PERM = true, AFTER_DRAIN = false;
    u16* H; const float* lbl;
    DI void operator()(const f32x4 (&acc)[2][2][4][2], const Unit& u, int wr, int wc, int fr, int fq) const {
        const int region = (u.pn * 256) >> 9;
        EPI8 {
            const unsigned col = ECOL;
            f32x4 v0 = acc[ai][bj][m][0], v1 = acc[ai][bj][m][1];
            if (region <= 1) { _Pragma("unroll") for (int r = 0; r < 4; ++r) { v0[r] = gelu_tanh(v0[r]); v1[r] = gelu_tanh(v1[r]); } }
            else if (region == 3) {
                const f32x4 a0 = *(const f32x4*)(lbl + (col - 1536u)), a1 = *(const f32x4*)(lbl + (col - 1536u + 4u)), b0 = *(const f32x4*)(lbl + (col - 1024u)), b1 = *(const f32x4*)(lbl + (col - 1024u + 4u));
                _Pragma("unroll") for (int r = 0; r < 4; ++r) {
                    const float lb0 = 1.f / (1.f + __expf(b0[r] - a0[r])), lb1 = 1.f / (1.f + __expf(b1[r] - a1[r]));
                    v0[r] = __logf(lb0 + (1.f - lb0) * sigmoidf(v0[r])); v1[r] = __logf(lb1 + (1.f - lb1) * sigmoidf(v1[r]));
                }
            }
            else if (region >= 4) { _Pragma("unroll") for (int r = 0; r < 4; ++r) { v0[r] = siluf(v0[r]); v1[r] = siluf(v1[r]); } }
            *(u32x4*)(H + EOFF(3072)) = pk8(v0, v1);
            ESB;
        }
    }
};
struct EpiSplit {
    static constexpr bool PERM = true, AFTER_DRAIN = false;
    u16* d0; u16* d1; u16* d2; u16* d3; float scale0;
    DI void operator()(const f32x4 (&acc)[2][2][4][2], const Unit& u, int wr, int wc, int fr, int fq) const {
        const int reg = (u.pn * 256) >> 10;
        u16* D = reg == 0 ? d0 : (reg == 1 ? d1 : (reg == 2 ? d2 : d3));
        const float sc = reg == 0 ? scale0 : 1.f;
        EPI8 { *(u32x4*)(D + ((unsigned)EROW * 1024u + ((unsigned)ECOL & 1023u))) = pk8(acc[ai][bj][m][0] * sc, acc[ai][bj][m][1] * sc); ESB; }
    }
};
struct EpiZ {
    static constexpr bool PERM = true, AFTER_DRAIN = false;
    const float* res; float* out;
    DI void operator()(const f32x4 (&acc)[2][2][4][2], const Unit& u, int wr, int wc, int fr, int fq) const {
        EPI8 { const unsigned o = EOFF(1024);
            const f32x4 r0 = *(const f32x4*)(res + o), r1 = *(const f32x4*)(res + o + 4u);
            *(f32x4*)(out + o) = r0 * ALPHA + acc[ai][bj][m][0];
            *(f32x4*)(out + o + 4u) = r1 * ALPHA + acc[ai][bj][m][1]; ESB; }
    }
};
struct EpiFFN {
    static constexpr bool PERM = true, AFTER_DRAIN = false;
    u16* Hd;
    DI void operator()(const f32x4 (&acc)[2][2][4][2], const Unit& u, int wr, int wc, int fr, int fq) const {
#pragma unroll
        for (int ai = 0; ai < 2; ++ai)
#pragma unroll
            for (int m = 0; m < 4; ++m) {
                f32x4 v0, v1;
#pragma unroll
                for (int r = 0; r < 4; ++r) { v0[r] = siluf(acc[ai][0][m][0][r]) * acc[ai][1][m][0][r]; v1[r] = siluf(acc[ai][0][m][1][r]) * acc[ai][1][m][1][r]; }
                *(u32x4*)(Hd + ((unsigned)EROW * (unsigned)DFF + (unsigned)(u.pn * 128 + wc * 32 + 8 * fq))) = pk8(v0, v1);
                ESB;
            }
    }
};
template <class Epi>
DI void run_gemm(char* lds, const u16* A, const u16* Bt, int M, int N, int K, const Epi& epi) {
    pg8::Gemm g; g.A = A; g.Bt = Bt; g.M = M; g.N = N; g.K = K;
    pg8::StaticOrder so; so.init(M, N, gridDim.x, blockIdx.x);
    pg8::gemm_phase<Epi, pg8::StaticOrder, true, true>((PG8_LAS unsigned char*)lds, g, so, epi);
}

DI void transpose_item(const float* __restrict__ W, int K, int N, u16* __restrict__ WT, int perm, int item, float* scr) {
    const int ntn = N >> 6, kb = item / ntn, nb = item % ntn, k0 = kb * 64, n0 = nb * 64, tid = get_tid();
    __syncthreads();
#pragma unroll
    for (int i = 0; i < 16; ++i) { const int kk = i * 4 + (tid >> 6), nn = tid & 63; scr[kk * 65 + nn] = W[(size_t)(k0 + kk) * N + n0 + nn]; }
    __syncthreads();
    const int n = tid >> 2, c = tid & 3;
    const float* s = scr + (c * 16) * 65 + n;
    u32x4 o0, o1;
    o0.x = pack2(s[0 * 65], s[1 * 65]); o0.y = pack2(s[2 * 65], s[3 * 65]); o0.z = pack2(s[4 * 65], s[5 * 65]); o0.w = pack2(s[6 * 65], s[7 * 65]);
    o1.x = pack2(s[8 * 65], s[9 * 65]); o1.y = pack2(s[10 * 65], s[11 * 65]); o1.z = pack2(s[12 * 65], s[13 * 65]); o1.w = pack2(s[14 * 65], s[15 * 65]);
    int nsrc = n0 + n, drow = nsrc;
    if (perm) { if (nsrc < DFF) drow = (nsrc >> 7) * 256 + (nsrc & 127); else { const int n2 = nsrc - DFF; drow = (n2 >> 7) * 256 + 128 + (n2 & 127); } }
    u32x4* dst = (u32x4*)(WT + (size_t)drow * K + k0 + c * 16);
    dst[0] = o0; dst[1] = o1;
}

DI void phase_prep(const Params& p, char* lds, int vbid, int nvb) {
    float* scr = (float*)lds;
    char* ws = p.ws;
    constexpr int T1 = 16 * 48, TS = 16 * 16, TKV = 16 * 32, TFI = 16 * 88, TFO = 44 * 16;
    constexpr int NTR = T1 + TS + 2 * TS + 2 * TKV + 2 * TS + 2 * TFI + 2 * TFO + T1 + TS;
    constexpr int NXC = NT * DM / 2048, NMC = 2048 * DM / 2048;
    for (int it = vbid; it < NTR + NXC + NMC; it += nvb) {
        int r = it;
        if (r < NTR) {
            if (r < T1) { transpose_item(p.in[9], 1024, 3072, (u16*)(ws + O_WT_EVIN), 0, r, scr); continue; } r -= T1;
            if (r < TS) { transpose_item(p.in[10], 1024, 1024, (u16*)(ws + O_WT_EVOUT), 0, r, scr); continue; } r -= TS;
            if (r < 2 * TS) { const int l = r / TS; transpose_item(p.in[4] + (size_t)l * 1024 * 1024, 1024, 1024, (u16*)(ws + O_WT_WQ + l * 2 * MB), 0, r % TS, scr); continue; } r -= 2 * TS;
            if (r < 2 * TKV) { const int l = r / TKV; transpose_item(p.in[5] + (size_t)l * 1024 * 2048, 1024, 2048, (u16*)(ws + O_WT_WKV + l * 4 * MB), 0, r % TKV, scr); continue; } r -= 2 * TKV;
            if (r < 2 * TS) { const int l = r / TS; transpose_item(p.in[6] + (size_t)l * 1024 * 1024, 1024, 1024, (u16*)(ws + O_WT_WO + l * 2 * MB), 0, r % TS, scr); continue; } r -= 2 * TS;
            if (r < 2 * TFI) { const int l = r / TFI; transpose_item(p.in[7] + (size_t)l * 1024 * 5632, 1024, 5632, (u16*)(ws + O_WT_FIN + l * 11 * MB), 1, r % TFI, scr); continue; } r -= 2 * TFI;
            if (r < 2 * TFO) { const int l = r / TFO; transpose_item(p.in[8] + (size_t)l * 2816 * 1024, 2816, 1024, (u16*)(ws + O_WT_FOUT + l * (11 * MB / 2)), 0, r % TFO, scr); continue; } r -= 2 * TFO;
            if (r < T1) { transpose_item(p.in[17], 1024, 3072, (u16*)(ws + O_WT_QKV), 0, r, scr); continue; } r -= T1;
            transpose_item(p.in[18], 1024, 1024, (u16*)(ws + O_WT_ODOUT), 0, r, scr);
            continue;
        }
        r -= NTR;
        const float* src; u16* dst;
        if (r < NXC) { src = p.in[0]; dst = (u16*)(ws + O_XB); } else { r -= NXC; src = p.in[1]; dst = (u16*)(ws + O_MEMB); }
        const size_t e = (size_t)r * 2048 + get_tid() * 8;
        const f32x4 a = *(const f32x4*)(src + e), b = *(const f32x4*)(src + e + 4);
        u32x4 o; o.x = pack2(a[0], a[1]); o.y = pack2(a[2], a[3]); o.z = pack2(b[0], b[1]); o.w = pack2(b[2], b[3]);
        *(u32x4*)(dst + e) = o;
    }
}

DI void phase_ln(const float* __restrict__ g, const float* __restrict__ bta, float* xio, u16* xb) {
    const int tid8 = get_tid8(), lane = tid8 & 63, gw = blockIdx.x * 8 + (tid8 >> 6), nw = gridDim.x * 8;
    for (int row = gw; row < NT; row += nw) {
        f32x4* xr = (f32x4*)(xio + (size_t)row * 1024);
        f32x4 v[4]; float s = 0.f;
#pragma unroll
        for (int j = 0; j < 4; ++j) { v[j] = xr[lane + 64 * j]; s += (v[j][0] + v[j][1]) + (v[j][2] + v[j][3]); }
#pragma unroll
        for (int o = 1; o < 64; o <<= 1) s += __shfl_xor(s, o);
        const float mean = s * (1.f / 1024.f); float q = 0.f;
#pragma unroll
        for (int j = 0; j < 4; ++j) { v[j] = v[j] - mean; q += (v[j][0] * v[j][0] + v[j][1] * v[j][1]) + (v[j][2] * v[j][2] + v[j][3] * v[j][3]); }
#pragma unroll
        for (int o = 1; o < 64; o <<= 1) q += __shfl_xor(q, o);
        const float rstd = rsqrtf(q * (1.f / 1024.f) + LN_EPS);
#pragma unroll
        for (int j = 0; j < 4; ++j) {
            const f32x4 gg = ((const f32x4*)g)[lane + 64 * j], bb = ((const f32x4*)bta)[lane + 64 * j];
            const f32x4 y = v[j] * rstd * gg + bb;
            xr[lane + 64 * j] = y;
            u32x2 o; o.x = pack2(y[0], y[1]); o.y = pack2(y[2], y[3]);
            ((u32x2*)(xb + (size_t)row * 1024))[lane + 64 * j] = o;
        }
    }
}

DI void gmlp_item(const Params& p, int item, char* lds) {
    const int tid = get_tid(), lane = tid & 63, w = tid >> 6, wr = w >> 1, wc = w & 1, fr = lane & 15, fq = lane >> 4;
    const int g = item & 3, n = (item >> 2) & 15, b = item >> 6;
    const u16* H = (const u16*)(p.ws + O_H);
    u16* YM = (u16*)(p.ws + O_YM);
    u16* sW = (u16*)lds; u16* sV = sW + 128 * 136;
    const size_t row_base = (size_t)b * SEQ + n * 128;
    __syncthreads();
    {
        const float* Wg = p.in[11] + (size_t)g * 128 * 128;
#pragma unroll 4
        for (int c = tid; c < 128 * 32; c += 256) {
            const int t = c >> 5, s4 = (c & 31) * 4;
            const f32x4 v = *(const f32x4*)(Wg + t * 128 + s4);
            u32x2 o; o.x = pack2(s4 + 0 <= t ? v[0] : 0.f, s4 + 1 <= t ? v[1] : 0.f); o.y = pack2(s4 + 2 <= t ? v[2] : 0.f, s4 + 3 <= t ? v[3] : 0.f);
            *(u32x2*)(sW + t * 136 + s4) = o;
        }
    }
    {
        const int r = tid >> 1, half = tid & 1;
        const u16* src = H + (row_base + r) * 3072 + 512 + g * 128 + half * 64;
        float x[64]; float s = 0.f;
#pragma unroll
        for (int j = 0; j < 8; ++j) {
            const u32x4 q = *(const u32x4*)(src + j * 8);
#pragma unroll
            for (int e = 0; e < 4; ++e) { x[j * 8 + 2 * e] = __uint_as_float(q[e] << 16); x[j * 8 + 2 * e + 1] = __uint_as_float(q[e] & 0xffff0000u); }
        }
#pragma unroll
        for (int j = 0; j < 64; ++j) s += x[j];
        s += __shfl_xor(s, 1);
        const float mean = s * (1.f / 128.f); float q2 = 0.f;
#pragma unroll
        for (int j = 0; j < 64; ++j) { x[j] -= mean; q2 += x[j] * x[j]; }
        q2 += __shfl_xor(q2, 1);
        const float rstd = rsqrtf(q2 * (1.f / 128.f) + LN_EPS);
        const float* lg = p.in[13] + g * 128 + half * 64; const float* lb = p.in[14] + g * 128 + half * 64;
#pragma unroll
        for (int j = 0; j < 64; ++j) sV[(half * 64 + j) * 136 + r] = f2bf(x[j] * rstd * lg[j] + lb[j]);
    }
    __syncthreads();
    f32x4 acc[4][4];
#pragma unroll
    for (int i = 0; i < 4; ++i)
#pragma unroll
        for (int j = 0; j < 4; ++j) acc[i][j] = (f32x4){0.f, 0.f, 0.f, 0.f};
    const u16* cA = sW + (wr * 64 + fr) * 136 + fq * 8;
    const u16* cB = sV + (wc * 64 + fr) * 136 + fq * 8;
#pragma unroll
    for (int ks = 0; ks < 4; ++ks) {
        bf16x8 a[4], bb[4];
#pragma unroll
        for (int i = 0; i < 4; ++i) { a[i] = *(const bf16x8*)(cA + i * 16 * 136 + ks * 32); bb[i] = *(const bf16x8*)(cB + i * 16 * 136 + ks * 32); }
#pragma unroll
        for (int i = 0; i < 4; ++i)
#pragma unroll
            for (int j = 0; j < 4; ++j) acc[i][j] = mfma16(a[i], bb[j], acc[i][j]);
    }
    const float* bs = p.in[12] + g * 128;
#pragma unroll
    for (int mi = 0; mi < 4; ++mi)
#pragma unroll
        for (int i = 0; i < 4; ++i) {
            const int t = wr * 64 + mi * 16 + fq * 4 + i; const float bt = bs[t];
#pragma unroll
            for (int ni = 0; ni < 4; ++ni) {
                const int c = wc * 64 + ni * 16 + fr;
                const float u = bf2f(H[(row_base + t) * 3072 + g * 128 + c]);
                YM[(row_base + t) * 1024 + g * 128 + c] = f2bf(u * (acc[mi][ni][i] + bt));
            }
        }
}

template <int ROWS, int COLS, int LD>
DI void stage_tile(u16* s, const u16* g, int ld) {
    constexpr int CPR = COLS / 8, TOT = ROWS * CPR;
    const int tid = get_tid();
#pragma unroll
    for (int c0 = 0; c0 < TOT; c0 += 256) { const int c = c0 + tid, r = c / CPR, cc = (c % CPR) * 8; *(u32x4*)(s + r * LD + cc) = *(const u32x4*)(g + (size_t)r * ld + cc); }
}

DI void hgrn_prep_cum(const u16* src, int th, int ch, float* sTot, float (&cum)[32], float& total) {
    float run = 0.f;
#pragma unroll
    for (int j = 0; j < 32; ++j) { run += bf2f(src[(size_t)j * 3072 + 1536]); cum[j] = run; }
    sTot[th * 128 + ch] = run;
    __syncthreads();
    const float t0 = sTot[ch], t1 = sTot[128 + ch], off = th ? t0 : 0.f;
    total = t0 + t1;
#pragma unroll
    for (int j = 0; j < 32; ++j) cum[j] += off;
}

DI void hgrnA_item(const Params& p, int item, char* lds) {
    const int tid = get_tid(), lane = tid & 63, w = tid >> 6, fr = lane & 15, fq = lane >> 4;
    const int n = item & 31, bh = item >> 5, h = bh & 3, b = bh >> 2;
    const u16* H = (const u16*)(p.ws + O_H);
    u16* YM = (u16*)(p.ws + O_YM);
    float* U = p.out + (size_t)item * 16384;
    float* DEC = (float*)(p.ws + O_KM + 512 * 1024) + (size_t)item * 128;
    u16* sQ = (u16*)lds;
    u16* sKd = sQ + 64 * 136;
    u16* sKt = sKd + 64 * 136;
    u16* sI = sKt + 128 * 72;
    float* sTot = (float*)(sI + 128 * 72);
    u16* sAt = sKd;
    const int ch = tid & 127, th = tid >> 7;
    const size_t row_base = (size_t)b * SEQ + n * 64;
    __syncthreads();
    {
        const u16* src = H + (row_base + th * 32) * 3072 + h * 128 + ch;
        float cum[32]; float total;
        hgrn_prep_cum(src, th, ch, sTot, cum, total);
        if (th == 0) DEC[ch] = __expf(total);
        float prev = th ? sTot[ch] : 0.f;
#pragma unroll
        for (int j8 = 0; j8 < 4; ++j8) {
            unsigned kt[4], iv[4];
#pragma unroll
            for (int jj = 0; jj < 8; ++jj) {
                const int j = j8 * 8 + jj;
                const float c = cum[j], lf = c - prev; prev = c;
                const float q = bf2f(src[(size_t)j * 3072 + 1024]);
                const unsigned ivv = src[(size_t)j * 3072 + 2048];
                const float kc = 1.f - __expf(lf);
                sQ[(th * 32 + j) * 136 + ch] = f2bf(q * __expf(c));
                sKd[(th * 32 + j) * 136 + ch] = f2bf(kc * __expf(-c));
                const unsigned ktv = f2bf(kc * __expf(total - c));
                if (jj & 1) { kt[jj >> 1] |= ktv << 16; iv[jj >> 1] |= ivv << 16; } else { kt[jj >> 1] = ktv; iv[jj >> 1] = ivv; }
            }
            *(u32x4*)(sKt + ch * 72 + th * 32 + j8 * 8) = (u32x4){kt[0], kt[1], kt[2], kt[3]};
            *(u32x4*)(sI + ch * 72 + th * 32 + j8 * 8) = (u32x4){iv[0], iv[1], iv[2], iv[3]};
        }
    }
    __syncthreads();
    f32x4 at[4];
#pragma unroll
    for (int nt = 0; nt < 4; ++nt) at[nt] = (f32x4){0.f, 0.f, 0.f, 0.f};
#pragma unroll
    for (int ks = 0; ks < 4; ++ks) {
        const bf16x8 a = *(const bf16x8*)(sQ + (16 * w + fr) * 136 + ks * 32 + fq * 8);
#pragma unroll
        for (int nt = 0; nt < 4; ++nt) { const bf16x8 bb = *(const bf16x8*)(sKd + (nt * 16 + fr) * 136 + ks * 32 + fq * 8); at[nt] = mfma16(a, bb, at[nt]); }
    }
    __syncthreads();
#pragma unroll
    for (int nt = 0; nt < 4; ++nt)
#pragma unroll
        for (int i = 0; i < 4; ++i) { const int t = 16 * w + fq * 4 + i, s = nt * 16 + fr; sAt[t * 72 + s] = f2bf(s <= t ? at[nt][i] : 0.f); }
    __syncthreads();
    {
        f32x4 oacc[4][2];
#pragma unroll
        for (int mt = 0; mt < 4; ++mt) { oacc[mt][0] = (f32x4){0.f, 0.f, 0.f, 0.f}; oacc[mt][1] = (f32x4){0.f, 0.f, 0.f, 0.f}; }
#pragma unroll
        for (int ks = 0; ks < 2; ++ks) {
            bf16x8 bb[2];
#pragma unroll
            for (int nt = 0; nt < 2; ++nt) bb[nt] = *(const bf16x8*)(sI + (32 * w + nt * 16 + fr) * 72 + ks * 32 + fq * 8);
#pragma unroll
            for (int mt = 0; mt < 4; ++mt) {
                const bf16x8 a = *(const bf16x8*)(sAt + (mt * 16 + fr) * 72 + ks * 32 + fq * 8);
                oacc[mt][0] = mfma16(a, bb[0], oacc[mt][0]); oacc[mt][1] = mfma16(a, bb[1], oacc[mt][1]);
            }
        }
#pragma unroll
        for (int mt = 0; mt < 4; ++mt)
#pragma unroll
            for (int nt = 0; nt < 2; ++nt)
#pragma unroll
                for (int i = 0; i < 4; ++i)
                    YM[(row_base + mt * 16 + fq * 4 + i) * 1024 + 512 + h * 128 + 32 * w + nt * 16 + fr] = f2bf(oacc[mt][nt][i]);
    }
    {
        f32x4 u[2][8];
#pragma unroll
        for (int mt = 0; mt < 2; ++mt)
#pragma unroll
            for (int nt = 0; nt < 8; ++nt) u[mt][nt] = (f32x4){0.f, 0.f, 0.f, 0.f};
#pragma unroll
        for (int ks = 0; ks < 2; ++ks) {
            bf16x8 a[2];
#pragma unroll
            for (int mt = 0; mt < 2; ++mt) a[mt] = *(const bf16x8*)(sI + (32 * w + mt * 16 + fr) * 72 + ks * 32 + fq * 8);
#pragma unroll
            for (int nt = 0; nt < 8; ++nt) {
                const bf16x8 bb = *(const bf16x8*)(sKt + (nt * 16 + fr) * 72 + ks * 32 + fq * 8);
                u[0][nt] = mfma16(a[0], bb, u[0][nt]); u[1][nt] = mfma16(a[1], bb, u[1][nt]);
            }
        }
#pragma unroll
        for (int mt = 0; mt < 2; ++mt)
#pragma unroll
            for (int nt = 0; nt < 8; ++nt)
#pragma unroll
                for (int i = 0; i < 4; ++i) U[(32 * w + mt * 16 + fq * 4 + i) * 128 + nt * 16 + fr] = u[mt][nt][i];
    }
}

DI void hgrn_scan(const Params& p) {
    const int tid = get_tid8();
    const float* U = p.out;
    const float* DEC = (const float*)(p.ws + O_KM + 512 * 1024);
    u16* ST = (u16*)(p.ws + O_XB);
    for (int idx = blockIdx.x * 512 + tid; idx < 32 * 4096; idx += gridDim.x * 512) {
        const int bh = idx >> 12, e4 = (idx & 4095) * 4, k = e4 & 127;
        f32x4 s = (f32x4){0.f, 0.f, 0.f, 0.f};
#pragma unroll 8
        for (int n = 0; n < 32; ++n) {
            const size_t item = (size_t)bh * 32 + n;
            const f32x4 u = *(const f32x4*)(U + item * 16384 + e4);
            const f32x4 d = *(const f32x4*)(DEC + item * 128 + k);
            u32x2 o; o.x = pack2(s[0], s[1]); o.y = pack2(s[2], s[3]);
            *(u32x2*)(ST + item * 16384 + e4) = o;
            s = d * s + u;
        }
    }
}

DI void hgrnC_item(const Params& p, int item, char* lds) {
    const int tid = get_tid(), lane = tid & 63, w = tid >> 6, fr = lane & 15, fq = lane >> 4;
    const int n = item & 31, bh = item >> 5, h = bh & 3, b = bh >> 2;
    const u16* H = (const u16*)(p.ws + O_H);
    u16* YM = (u16*)(p.ws + O_YM);
    const u16* ST = (const u16*)(p.ws + O_XB) + (size_t)item * 16384;
    u16* sQ = (u16*)lds;
    u16* sS = sQ + 64 * 136;
    float* sTot = (float*)(sS + 128 * 136);
    float* sSsq = sTot + 256;
    const float* gn = p.in[15] + h * 128;
    const int ch = tid & 127, th = tid >> 7;
    const size_t row_base = (size_t)b * SEQ + n * 64;
    __syncthreads();
    stage_tile<128, 128, 136>(sS, ST, 128);
    {
        const u16* src = H + (row_base + th * 32) * 3072 + h * 128 + ch;
        float cum[32]; float total;
        hgrn_prep_cum(src, th, ch, sTot, cum, total);
#pragma unroll
        for (int j = 0; j < 32; ++j) sQ[(th * 32 + j) * 136 + ch] = f2bf(bf2f(src[(size_t)j * 3072 + 1024]) * __expf(cum[j]));
    }
    __syncthreads();
    f32x4 oacc[4][2];
#pragma unroll
    for (int mt = 0; mt < 4; ++mt) { oacc[mt][0] = (f32x4){0.f, 0.f, 0.f, 0.f}; oacc[mt][1] = (f32x4){0.f, 0.f, 0.f, 0.f}; }
#pragma unroll
    for (int ks = 0; ks < 4; ++ks) {
        bf16x8 bb[2];
#pragma unroll
        for (int nt = 0; nt < 2; ++nt) bb[nt] = *(const bf16x8*)(sS + (32 * w + nt * 16 + fr) * 136 + ks * 32 + fq * 8);
#pragma unroll
        for (int mt = 0; mt < 4; ++mt) {
            const bf16x8 a = *(const bf16x8*)(sQ + (mt * 16 + fr) * 136 + ks * 32 + fq * 8);
            oacc[mt][0] = mfma16(a, bb[0], oacc[mt][0]); oacc[mt][1] = mfma16(a, bb[1], oacc[mt][1]);
        }
    }
#pragma unroll
    for (int mt = 0; mt < 4; ++mt)
#pragma unroll
        for (int i = 0; i < 4; ++i) {
#pragma unroll
            for (int nt = 0; nt < 2; ++nt) oacc[mt][nt][i] += bf2f(YM[(row_base + mt * 16 + fq * 4 + i) * 1024 + 512 + h * 128 + 32 * w + nt * 16 + fr]);
            float q = oacc[mt][0][i] * oacc[mt][0][i] + oacc[mt][1][i] * oacc[mt][1][i];
            q += __shfl_xor(q, 1); q += __shfl_xor(q, 2); q += __shfl_xor(q, 4); q += __shfl_xor(q, 8);
            if (fr == 0) sSsq[w * 64 + mt * 16 + fq * 4 + i] = q;
        }
    __syncthreads();
#pragma unroll
    for (int mt = 0; mt < 4; ++mt)
#pragma unroll
        for (int i = 0; i < 4; ++i) {
            const int t = mt * 16 + fq * 4 + i;
            const float tot = (sSsq[t] + sSsq[64 + t]) + (sSsq[128 + t] + sSsq[192 + t]);
            const float r = rsqrtf(tot * (1.f / 128.f) + LN_EPS);
#pragma unroll
            for (int nt = 0; nt < 2; ++nt) {
                const int v = 32 * w + nt * 16 + fr;
                const float gate = bf2f(H[(row_base + t) * 3072 + 2560 + h * 128 + v]);
                YM[(row_base + t) * 1024 + 512 + h * 128 + v] = f2bf(oacc[mt][nt][i] * r * gn[v] * gate);
            }
        }
}

template <int NDC, class MaskF>
DI void attn_keytile(const u16* Kg, int ldk, const u16* Vtg, int ldv, const bf16x8 (&bq)[NDC * 2], f32x4 (&oacc)[NDC * 4], float& m, float& l,
                     u16* sK, u16* sV, const MaskF& maskf, int fr, int fq) {
    f32x4 sacc[8];
#pragma unroll
    for (int i = 0; i < 8; ++i) sacc[i] = (f32x4){0.f, 0.f, 0.f, 0.f};
#pragma unroll
    for (int dc = 0; dc < NDC; ++dc) {
        __syncthreads();
        stage_tile<128, 64, 72>(sK, Kg + dc * 64, ldk);
        __syncthreads();
#pragma unroll
        for (int ks = 0; ks < 2; ++ks)
#pragma unroll
            for (int mt = 0; mt < 8; ++mt) { const bf16x8 a = *(const bf16x8*)(sK + (mt * 16 + fr) * 72 + ks * 32 + fq * 8); sacc[mt] = mfma16(a, bq[dc * 2 + ks], sacc[mt]); }
    }
    float mx = -1e30f;
#pragma unroll
    for (int mt = 0; mt < 8; ++mt)
#pragma unroll
        for (int i = 0; i < 4; ++i) { const float s = maskf(sacc[mt][i], mt * 16 + fq * 4 + i); sacc[mt][i] = s; mx = fmaxf(mx, s); }
    mx = fmaxf(mx, __shfl_xor(mx, 16)); mx = fmaxf(mx, __shfl_xor(mx, 32));
    const float mnew = fmaxf(m, mx), corr = __expf(m - mnew);
    l *= corr;
#pragma unroll
    for (int i = 0; i < NDC * 4; ++i) oacc[i] = oacc[i] * corr;
    float ps = 0.f;
#pragma unroll
    for (int mt = 0; mt < 8; ++mt)
#pragma unroll
        for (int i = 0; i < 4; ++i) { const float pe = __expf(sacc[mt][i] - mnew); ps += pe; sacc[mt][i] = pe; }
    l += ps; m = mnew;
    bf16x8 pb[4];
#pragma unroll
    for (int s = 0; s < 4; ++s) pb[s] = pack8(sacc[2 * s], sacc[2 * s + 1]);
#pragma unroll
    for (int dc = 0; dc < NDC; ++dc) {
        __syncthreads();
        stage_tile<64, 128, 136>(sV, Vtg + (size_t)dc * 64 * ldv, ldv);
        __syncthreads();
#pragma unroll
        for (int s = 0; s < 4; ++s)
#pragma unroll
            for (int mt = 0; mt < 4; ++mt) {
                const u16* va = sV + (mt * 16 + fr) * 136 + 32 * s + fq * 4;
                const bf16x8 a = mk8(*(const u32x2*)va, *(const u32x2*)(va + 16));
                oacc[dc * 4 + mt] = mfma16(a, pb[s], oacc[dc * 4 + mt]);
            }
    }
}

struct MaskNone { DI float operator()(float s, int) const { return s; } };
struct MaskMoba {
    int key0, tq, qblk; unsigned sel; float slope;
    DI float operator()(float s, int key) const {
        const int tk = key0 + key, j = key0 >> 8;
        const bool ok = (j < qblk) ? ((sel >> j) & 1u) : (tk <= tq);
        return ok ? s - slope * (float)(tq - tk) : -1e30f;
    }
};

DI void cross_item(const Params& p, int l, int item, char* lds) {
    const int tid = get_tid(), lane = tid & 63, w = tid >> 6, fr = lane & 15, fq = lane >> 4;
    const int qt = item & 31, h = (item >> 5) & 3, b = item >> 7;
    const u16* Q = (const u16*)(p.ws + O_H);
    const u16* Kd = (const u16*)(p.ws + O_KVK + l * 4 * MB);
    const u16* Vt = (const u16*)(p.ws + O_KVV + l * 4 * MB);
    u16* O = (u16*)(p.ws + O_YM);
    u16* sK = (u16*)lds; u16* sV = sK + 128 * 72;
    const size_t qrow = (size_t)b * SEQ + qt * 64 + w * 16 + fr;
    bf16x8 bq[8];
#pragma unroll
    for (int i = 0; i < 8; ++i) bq[i] = *(const bf16x8*)(Q + qrow * 1024 + h * 256 + i * 32 + fq * 8);
    f32x4 oacc[16];
#pragma unroll
    for (int i = 0; i < 16; ++i) oacc[i] = (f32x4){0.f, 0.f, 0.f, 0.f};
    float m = -1e30f, lsum = 0.f;
    MaskNone mk;
    for (int kt = 0; kt < 2; ++kt)
        attn_keytile<4>(Kd + ((size_t)b * 256 + kt * 128) * 1024 + h * 256, 1024, Vt + ((size_t)(b * 4 + h) * 256) * 256 + kt * 128, 256, bq, oacc, m, lsum, sK, sV, mk, fr, fq);
    lsum += __shfl_xor(lsum, 16); lsum += __shfl_xor(lsum, 32);
    const float inv = 1.f / lsum;
#pragma unroll
    for (int i = 0; i < 16; ++i) {
        u32x2 o; o.x = pack2(oacc[i][0] * inv, oacc[i][1] * inv); o.y = pack2(oacc[i][2] * inv, oacc[i][3] * inv);
        *(u32x2*)(O + qrow * 1024 + h * 256 + i * 16 + fq * 4) = o;
    }
}

DI void moba_item(const Params& p, int item, char* lds) {
    const int tid = get_tid(), lane = tid & 63, w = tid >> 6, fr = lane & 15, fq = lane >> 4;
    const int qt = 31 - (item >> 7), bh = item & 127, h = bh & 15, b = bh >> 4;
    const u16* Q = (const u16*)(p.ws + O_H);
    const u16* Kd = (const u16*)(p.ws + O_H + 32 * MB);
    const u16* Vt = (const u16*)(p.ws + O_H + 64 * MB);
    const float* KM = (const float*)(p.ws + O_KM);
    u16* O = (u16*)(p.ws + O_YM);
    u16* sK = (u16*)lds; u16* sV = sK + 128 * 72;
    const int q0 = qt * 64, qblk = q0 >> 8, tq = q0 + w * 16 + fr;
    const size_t qrow = (size_t)b * SEQ + tq;
    bf16x8 bq[2];
#pragma unroll
    for (int i = 0; i < 2; ++i) bq[i] = *(const bf16x8*)(Q + qrow * 1024 + h * 64 + i * 32 + fq * 8);
    unsigned sel = 0;
    if (qblk > 0) {
        float aff[8];
#pragma unroll
        for (int j = 0; j < 8; ++j) aff[j] = 0.f;
        const u16* qp = Q + qrow * 1024 + h * 64;
        const float* km = KM + (size_t)bh * 8 * 64;
#pragma unroll
        for (int d8 = 0; d8 < 8; ++d8) {
            const u32x4 qv = *(const u32x4*)(qp + d8 * 8);
            float qf[8];
#pragma unroll
            for (int e = 0; e < 4; ++e) { qf[2 * e] = __uint_as_float(qv[e] << 16); qf[2 * e + 1] = __uint_as_float(qv[e] & 0xffff0000u); }
#pragma unroll
            for (int j = 0; j < 7; ++j)
                if (j < qblk) {
#pragma unroll
                    for (int e = 0; e < 8; ++e) aff[j] += qf[e] * km[j * 64 + d8 * 8 + e];
                }
        }
#pragma unroll
        for (int j = 0; j < 7; ++j) {
            int rank = 0;
#pragma unroll
            for (int j2 = 0; j2 < 7; ++j2) if (j2 < qblk && j2 != j && (aff[j2] > aff[j] || (aff[j2] == aff[j] && j2 < j))) ++rank;
            if (j < qblk && rank < 3) sel |= 1u << j;
        }
    }
    f32x4 oacc[4];
#pragma unroll
    for (int i = 0; i < 4; ++i) oacc[i] = (f32x4){0.f, 0.f, 0.f, 0.f};
    float m = -1e30f, lsum = 0.f;
    MaskMoba mk; mk.tq = tq; mk.qblk = qblk; mk.sel = sel; mk.slope = exp2f(-0.5f * (float)(h + 1));
    for (int kt = q0 >> 7; kt >= 0; --kt) {
        mk.key0 = kt * 128;
        attn_keytile<1>(Kd + ((size_t)b * SEQ + kt * 128) * 1024 + h * 64, 1024, Vt + ((size_t)(b * 16 + h) * 64) * 2048 + kt * 128, 2048, bq, oacc, m, lsum, sK, sV, mk, fr, fq);
    }
    lsum += __shfl_xor(lsum, 16); lsum += __shfl_xor(lsum, 32);
    const float inv = 1.f / lsum;
#pragma unroll
    for (int i = 0; i < 4; ++i) {
        u32x2 o; o.x = pack2(oacc[i][0] * inv, oacc[i][1] * inv); o.y = pack2(oacc[i][2] * inv, oacc[i][3] * inv);
        *(u32x2*)(O + qrow * 1024 + h * 64 + i * 16 + fq * 4) = o;
    }
}

DI void kmean_item(const Params& p, int item, char* lds) {
    const int tid = get_tid(), d = tid & 63, part = tid >> 6;
    const int j = item & 7, bh = item >> 3, h = bh & 15, b = bh >> 4;
    const u16* Kd = (const u16*)(p.ws + O_H + 32 * MB) + ((size_t)b * SEQ + j * 256 + part * 64) * 1024 + h * 64 + d;
    float* red = (float*)lds;
    float s = 0.f;
#pragma unroll 8
    for (int i = 0; i < 64; ++i) s += bf2f(Kd[(size_t)i * 1024]);
    __syncthreads();
    red[part * 64 + d] = s;
    __syncthreads();
    if (part == 0) ((float*)(p.ws + O_KM))[(size_t)item * 64 + d] = ((red[d] + red[64 + d]) + (red[128 + d] + red[192 + d])) * (1.f / 256.f);
}

DI void vtrans_item(const u16* src, int src_ld, u16* dst, int dst_ld, char* lds) {
    const int tid = get_tid();
    u16* sT = (u16*)lds;
    __syncthreads();
#pragma unroll
    for (int i = 0; i < 2; ++i) {
        const int c = tid + i * 256, r = c >> 3, cc = (c & 7) * 8;
        const u32x4 v = *(const u32x4*)(src + (size_t)r * src_ld + cc);
#pragma unroll
        for (int e = 0; e < 4; ++e) { sT[(cc + 2 * e) * 72 + r] = (u16)(v[e] & 0xffffu); sT[(cc + 2 * e + 1) * 72 + r] = (u16)(v[e] >> 16); }
    }
    __syncthreads();
#pragma unroll
    for (int i = 0; i < 2; ++i) {
        const int c = tid + i * 256, r = c >> 3, cc = (c & 7) * 8;
        *(u32x4*)(dst + (size_t)r * dst_ld + cc) = *(const u32x4*)(sT + r * 72 + cc);
    }
}
DI void vtrans_cross(const Params& p, int item, char* lds) {
    const int dt = item & 3, mt = (item >> 2) & 3, h = (item >> 4) & 3, b = (item >> 6) & 7, l = item >> 9;
    const u16* src = (const u16*)(p.ws + O_VRAW + l * 4 * MB) + ((size_t)b * 256 + mt * 64) * 1024 + h * 256 + dt * 64;
    u16* dst = (u16*)(p.ws + O_KVV + l * 4 * MB) + ((size_t)((b * 4 + h) * 256 + dt * 64)) * 256 + mt * 64;
    vtrans_item(src, 1024, dst, 256, lds);
}
DI void vtrans_moba(const Params& p, int item, char* lds) {
    const int tt = item & 31, h = (item >> 5) & 15, b = item >> 9;
    const u16* src = (const u16*)(p.ws + O_YM) + ((size_t)b * SEQ + tt * 64) * 1024 + h * 64;
    u16* dst = (u16*)(p.ws + O_H + 64 * MB) + ((size_t)((b * 16 + h) * 64)) * 2048 + tt * 64;
    vtrans_item(src, 1024, dst, 2048, lds);
}

__global__ void __launch_bounds__(512, 2) mega(Params p) {
    extern __shared__ __attribute__((aligned(16))) char lds[];
    cg::grid_group grid = cg::this_grid();
    char* ws = p.ws;
    volatile LAS unsigned* xst = (volatile LAS unsigned*)(lds + 2 * LDS_MAIN);
    if (threadIdx.x == 0) { xst[0] = 0u; xst[1] = 0u; xst[2] = 0u; xst[3] = 0u; }
    __syncthreads();
    const XcdBarrier xb = xcd_barrier_post((unsigned*)(ws + O_BAR), xst);
    for (int pi = p.ph0; pi < p.ph1; ++pi) {
        int t_ = threadIdx.x; asm volatile("" : "+v"(t_));
        ws = p.ws; asm volatile("" : "+s"(ws));
        u16* XB = (u16*)(ws + O_XB); u16* Hb = (u16*)(ws + O_H); u16* YM = (u16*)(ws + O_YM);
        const int vb = t_ >> 8, vbid = blockIdx.x * 2 + vb, nvb = gridDim.x * 2;
        char* vlds = lds + vb * LDS_MAIN;
        const int ph = pi < 3 ? pi : (pi < 5 ? 21 + pi : pi - 2);
        const int l = (ph >= 12 && ph < 24) ? 1 : 0;
        const bool is_gemm = (ph == 1 || ph == 3 || ph == 5 || ph == 7 || ph == 9 || ph == 10 || ph == 12 || ph == 15 || ph == 17 || ph == 19 || ph == 21 || ph == 22);
        if (is_gemm) {
            for (int sub = 0; sub < (ph == 1 ? 2 : 1); ++sub) {
                const u16* A = XB; const u16* Bt = nullptr; int M = NT, N = 1024, K = 1024, et = 1;
                EpiSplit es; es.d0 = Hb; es.d1 = Hb; es.d2 = Hb; es.d3 = Hb; es.scale0 = 1.f;
                EpiZ ez; ez.res = p.out; ez.out = p.out;
                if (ph == 1 && sub == 0) { Bt = (const u16*)(ws + O_WT_EVIN); N = 3072; et = 0; }
                else if (ph == 1) { A = (const u16*)(ws + O_MEMB); Bt = (const u16*)(ws + O_WT_WKV); M = 2048; N = 4096;
                    es.d0 = (u16*)(ws + O_KVK); es.d1 = (u16*)(ws + O_VRAW); es.d2 = (u16*)(ws + O_KVK + 4 * MB); es.d3 = (u16*)(ws + O_VRAW + 4 * MB); }
                else if (ph == 5 || ph == 17) { Bt = (const u16*)(ws + O_WT_WQ + l * 2 * MB); es.scale0 = 0.0625f; }
                else if (ph == 12) { Bt = (const u16*)(ws + O_WT_QKV); N = 3072; es.d1 = (u16*)(ws + O_H + 32 * MB); es.d2 = YM; es.d3 = YM; es.scale0 = 0.125f; }
                else if (ph == 9 || ph == 21) { Bt = (const u16*)(ws + O_WT_FIN + l * 11 * MB); N = 2 * DFF; et = 3; }
                else {
                    et = 2;
                    const bool ffn = (ph == 10 || ph == 22);
                    A = ffn ? Hb : YM; K = ffn ? DFF : 1024;
                    if (ph == 3) ez.res = p.in[0];
                    const size_t wo = (ph == 3) ? O_WT_EVOUT : (ph == 15) ? O_WT_ODOUT : ffn ? (O_WT_FOUT + l * (11 * MB / 2)) : (O_WT_WO + l * 2 * MB);
                    Bt = (const u16*)(ws + wo);
                }
                if (et == 0) { EpiH0 e0; e0.H = Hb; e0.lbl = p.in[16]; run_gemm(lds, A, Bt, M, N, K, e0); }
                else if (et == 1) run_gemm(lds, A, Bt, M, N, K, es);
                else if (et == 2) run_gemm(lds, A, Bt, M, N, K, ez);
                else { EpiFFN e; e.Hd = Hb; run_gemm(lds, A, Bt, M, N, K, e); }
            }
        } else
        switch (ph) {
        case 0: phase_prep(p, vlds, vbid, nvb); break;
        case 2: { for (int it = vbid; it < 1024 + 512 + 1024; it += nvb) { if (it < 1024) hgrnA_item(p, it, vlds); else if (it < 1536) gmlp_item(p, it - 1024, vlds); else vtrans_cross(p, it - 1536, vlds); } } break;
        case 24: hgrn_scan(p); break;
        case 25: { for (int it = vbid; it < 1024; it += nvb) hgrnC_item(p, it, vlds); } break;
        case 4: case 8: case 11: case 16: case 20: case 23: {
            const int k = (ph == 4 || ph == 16) ? 0 : ((ph == 8 || ph == 20) ? 1 : 2);
            phase_ln(p.in[2] + (l * 3 + k) * 1024, p.in[3] + (l * 3 + k) * 1024, p.out, XB);
        } break;
        case 6: case 18: { for (int it = vbid; it < 1024; it += nvb) cross_item(p, l, it, vlds); } break;
        case 13: { for (int it = vbid; it < 1024 + 4096; it += nvb) { if (it < 1024) kmean_item(p, it, vlds); else vtrans_moba(p, it - 1024, vlds); } } break;
        case 14: { for (int it = vbid; it < 4096; it += nvb) moba_item(p, it, vlds); } break;
        default: break;
        }
        if (pi + 1 < p.ph1) { if (p.use_cg) grid.sync(); else xcd_barrier(xb); }
    }
}

extern "C" void kernel_launch(void* const* d_in, const int* in_sizes, int n_in, void* d_out, int out_size, void* d_ws, size_t ws_size, hipStream_t stream) {
    static int grid = 0;
    if (grid == 0) {
        if (n_in != 19 || ws_size < WS_END) { fprintf(stderr, "kernel_launch: unexpected n_in %d / ws %zu (need %zu)\n", n_in, ws_size, (size_t)WS_END); grid = -1; return; }
        int dev = 0, cus = 0, per_cu = 0;
        (void)hipGetDevice(&dev);
        (void)hipDeviceGetAttribute(&cus, hipDeviceAttributeMultiprocessorCount, dev);
        if (hipFuncSetAttribute((const void*)mega, hipFuncAttributeMaxDynamicSharedMemorySize, LDS_BYTES) != hipSuccess) { fprintf(stderr, "hipFuncSetAttribute failed\n"); grid = -1; return; }
        if (hipOccupancyMaxActiveBlocksPerMultiprocessor(&per_cu, (const void*)mega, 512, LDS_BYTES) != hipSuccess || per_cu < 1) { fprintf(stderr, "occupancy query failed\n"); grid = -1; return; }
        grid = cus;
        grid -= grid % 8;
        fprintf(stderr, "kernel_launch: grid %d (cus %d per_cu %d)\n", grid, cus, per_cu);
    }
    if (grid < 0) return;
    Params p{};
    for (int i = 0; i < 19; ++i) p.in[i] = (const float*)d_in[i];
    p.out = (float*)d_out; p.ws = (char*)d_ws;
    p.ph0 = 0; p.ph1 = NPHASE; p.use_cg = 0;
    if (hipMemsetAsync((char*)d_ws + O_BAR, 0, XCD_BAR_WORDS * 4, stream) != hipSuccess) { fprintf(stderr, "memset failed\n"); return; }
    void* args[] = {&p};
    hipError_t e = hipLaunchCooperativeKernel((void*)mega, dim3(grid), dim3(512), args, LDS_BYTES, stream);
    if (e != hipSuccess) fprintf(stderr, "cooperative launch failed: %s (grid %d)\n", hipGetErrorString(e), grid);
}
```

```cpp
#include <hip/hip_runtime.h>
#include <hip/hip_cooperative_groups.h>
#include <cstdio>
#include <cstdint>
namespace cg = cooperative_groups;

#ifndef MULTI_LAUNCH
#define MULTI_LAUNCH 0
#endif

#ifndef PHMASK
#define PHMASK 0xFFFFFFFFu
#endif
#define EN(x) ((PHMASK >> (x)) & 1u)
#define DI __device__ __forceinline__
typedef unsigned short u16;
typedef short bf16x8 __attribute__((ext_vector_type(8)));
typedef float f32x4 __attribute__((ext_vector_type(4)));
typedef unsigned u32x4 __attribute__((ext_vector_type(4)));
typedef unsigned u32x2 __attribute__((ext_vector_type(2)));

constexpr int NT = 16384, DM = 1024, SEQ = 2048;
constexpr int DFF = 2816;
constexpr float ALPHA = 1.41421356237309515f;
constexpr float LN_EPS = 1e-5f;
constexpr int LDS_MAIN = 73728;
constexpr int LDS_BYTES = 2 * LDS_MAIN + 16;
constexpr int NPHASE = 26;

constexpr size_t MB = 1u << 20;
constexpr size_t O_WT_EVIN = 0;
constexpr size_t O_WT_EVOUT = O_WT_EVIN + 6 * MB;
constexpr size_t O_WT_WQ = O_WT_EVOUT + 2 * MB;
constexpr size_t O_WT_WKV = O_WT_WQ + 4 * MB;
constexpr size_t O_WT_WO = O_WT_WKV + 8 * MB;
constexpr size_t O_WT_FIN = O_WT_WO + 4 * MB;
constexpr size_t O_WT_FOUT = O_WT_FIN + 22 * MB;
constexpr size_t O_WT_QKV = O_WT_FOUT + 11 * MB;
constexpr size_t O_WT_ODOUT = O_WT_QKV + 6 * MB;
constexpr size_t O_XB = O_WT_ODOUT + 2 * MB;
constexpr size_t O_H = O_XB + 32 * MB;
constexpr size_t O_YM = O_H + 96 * MB;
constexpr size_t O_MEMB = O_YM + 32 * MB;
constexpr size_t O_KVK = O_MEMB + 4 * MB;
constexpr size_t O_KVV = O_KVK + 8 * MB;
constexpr size_t O_KM = O_KVV + 8 * MB;
constexpr size_t O_BAR = O_KM + MB;
constexpr size_t O_VRAW = O_BAR + MB;
constexpr size_t WS_END = O_VRAW + 8 * MB;

struct Params { const float* in[19]; float* out; char* ws; int ph0, ph1; int use_cg, pad; };

DI int get_tid8() { int t = threadIdx.x; asm volatile("" : "+v"(t)); return t; }
DI int get_tid() { int t = threadIdx.x & 255; asm volatile("" : "+v"(t)); return t; }
DI u16 f2bf(float x) { unsigned u = __float_as_uint(x); u += 0x7fffu + ((u >> 16) & 1u); return (u16)(u >> 16); }
DI float bf2f(u16 h) { return __uint_as_float(((unsigned)h) << 16); }
DI unsigned pack2(float a, float b) { return (unsigned)f2bf(a) | ((unsigned)f2bf(b) << 16); }
DI f32x4 mfma16(bf16x8 a, bf16x8 b, f32x4 c) { return __builtin_amdgcn_mfma_f32_16x16x32_bf16(a, b, c, 0, 0, 0); }
DI bf16x8 mk8(u32x2 lo, u32x2 hi) { u32x4 t; t.x = lo.x; t.y = lo.y; t.z = hi.x; t.w = hi.y; return __builtin_bit_cast(bf16x8, t); }
DI bf16x8 pack8(f32x4 a, f32x4 b) { u32x4 t; t.x = pack2(a[0], a[1]); t.y = pack2(a[2], a[3]); t.z = pack2(b[0], b[1]); t.w = pack2(b[2], b[3]); return __builtin_bit_cast(bf16x8, t); }
DI float gelu_tanh(float x) { float y = 0.7978845608028654f * (x + 0.044715f * x * x * x); float t = 1.f - 2.f / (1.f + __expf(2.f * y)); return 0.5f * x * (1.f + t); }
DI float sigmoidf(float x) { return 1.f / (1.f + __expf(-x)); }
DI float siluf(float x) { return x / (1.f + __expf(-x)); }


#define XB_TMO      128
#define XB_XCNT(j)  (256  + 64 * (j))
#define XB_XSUB(j)  (1280 + 64 * (j))
#define XB_XGEN(j)  (2304 + 64 * (j))
#define XB_TOP      3328
#define XB_TOPGEN   3392
#define XCD_BAR_WORDS 3456
#define XB_SPIN_CAP (1u << 18)
#define LAS __attribute__((address_space(3)))
DI unsigned xb_ld(unsigned* p) { return __hip_atomic_load(p, __ATOMIC_RELAXED, __HIP_MEMORY_SCOPE_AGENT); }
DI unsigned xb_add(unsigned* p, unsigned v) { return __hip_atomic_fetch_add(p, v, __ATOMIC_RELAXED, __HIP_MEMORY_SCOPE_AGENT); }
DI unsigned xb_xcc_id() { return (unsigned)__builtin_amdgcn_s_getreg((3 << 11) | 20) & 0xFu; }
#define XB_SPIN(cond, bar) do { unsigned _sp = 0; while (cond) { __builtin_amdgcn_s_sleep(1); \
    if ((++_sp & 255u) == 0u) { if (xb_ld(&(bar)[XB_TMO])) break; if (_sp > XB_SPIN_CAP) { atomicAdd(&(bar)[XB_TMO], 1u); break; } } } } while (0)
struct XcdBarrier { unsigned* bar; unsigned x; volatile LAS unsigned* st; };
DI XcdBarrier xcd_barrier_post(unsigned* bar, volatile LAS unsigned* st) {
    XcdBarrier b; b.bar = bar; b.x = xb_xcc_id(); b.st = st;
    if (threadIdx.x == 0) (void)xb_add(&bar[XB_XCNT(b.x)], 1u);
    return b;
}
DI void xcd_barrier_complete(unsigned* bar, unsigned x, unsigned& nloc, unsigned& nx) {
    const unsigned G = gridDim.x * gridDim.y * gridDim.z;
    unsigned sum, cnt, mine, sp = 0u;
    for (;;) {
        sum = 0u; cnt = 0u; mine = 0u;
#pragma unroll
        for (unsigned j = 0; j < 16; ++j) { const unsigned c = xb_ld(&bar[XB_XCNT(j)]); sum += c; cnt += (c > 0u) ? 1u : 0u; mine = (j == x) ? c : mine; }
        if (sum == G) break;
        __builtin_amdgcn_s_sleep(1);
        if ((++sp & 255u) == 0u) { if (xb_ld(&bar[XB_TMO])) break; if (sp > XB_SPIN_CAP) { atomicAdd(&bar[XB_TMO], 1u); break; } }
    }
    nloc = mine > 0u ? mine : 1u; nx = cnt > 0u ? cnt : 1u;
}
DI void xcd_barrier(const XcdBarrier& b) {
    asm volatile("s_waitcnt vmcnt(0)" ::: "memory");
    __syncthreads();
    if (threadIdx.x == 0) {
        unsigned* bar = b.bar;
        __builtin_amdgcn_s_waitcnt(0);
        unsigned nloc = b.st[0], nx = b.st[1];
        if (nloc == 0u) { xcd_barrier_complete(bar, b.x, nloc, nx); b.st[0] = nloc; b.st[1] = nx; }
        const unsigned old = xb_add(&bar[XB_XSUB(b.x)], 1u);
        const unsigned gen = old / nloc;
        if (old + 1u == (gen + 1u) * nloc) {
            __builtin_amdgcn_fence(__ATOMIC_RELEASE, "agent");
            asm volatile("s_waitcnt vmcnt(0)" ::: "memory");
            const unsigned og = xb_add(&bar[XB_TOP], 1u);
            const unsigned tg = og / nx;
            if (og + 1u == (tg + 1u) * nx) xb_add(&bar[XB_TOPGEN], 1u);
            else XB_SPIN(xb_ld(&bar[XB_TOPGEN]) == tg, bar);
            __builtin_amdgcn_fence(__ATOMIC_ACQUIRE, "agent");
            xb_add(&bar[XB_XGEN(b.x)], 1u);
            asm volatile("s_waitcnt vmcnt(0)" ::: "memory");
        } else {
            XB_SPIN(xb_ld(&bar[XB_XGEN(b.x)]) == gen, bar);
            __builtin_amdgcn_fence(__ATOMIC_ACQUIRE, "agent");
            asm volatile("s_waitcnt vmcnt(0)" ::: "memory");
        }
    }
    __syncthreads();
}

namespace pg8 {
#define PG8_LAS __attribute__((address_space(3)))
typedef unsigned short bf16_t;
typedef short bf16x8 __attribute__((ext_vector_type(8)));
typedef float f32x4 __attribute__((ext_vector_type(4)));
typedef unsigned u32x4 __attribute__((ext_vector_type(4)));
constexpr int BM = 256, BK = 64, HALF = 128, HTB = HALF * BK * 2  , STAGE_BYTES = 8 * HTB, NXCD = 8, WGM = 8;

__host__ __device__ __forceinline__ int lds_byte(int r, int c) { const int st = (r >> 4) * 2 + (c >> 5), rr = r & 15, cc = c & 31, ob = rr * 64 + cc * 2; return st * 1024 + (ob ^ (((ob >> 9) & 1) << 5)); }
__host__ __device__ __forceinline__ void stage_rc(int b, int& R, int& C) { const int st = b / 1024, sb = b % 1024, swz = sb ^ (((sb >> 9) & 1) << 5); R = (st >> 1) * 16 + swz / 64; C = (st & 1) * 32 + (swz % 64) / 2; }
__host__ __device__ __forceinline__ int perm32(int rho) { const int n = rho >> 4, i = rho & 15; return 8 * (i >> 2) + 4 * n + (i & 3); }

struct Unit { int pm, pn; };
struct Gemm { const bf16_t* A; const bf16_t* Bt; int M, N, K; };

struct StaticOrder {
    int nM, nN, nwg, G, c;
    __host__ __device__ void init(int M, int N, int G_, int c_) { nM = M / BM; nN = N / BM; nwg = nM * nN; G = G_; c = c_; }
    __host__ __device__ bool next(int i, Unit& u) const {
        const long L = (long)i * G + c; if (L >= nwg) return false;
        int wgid = (int)L; { const int q = nwg / NXCD, r = nwg % NXCD, xcd = wgid % NXCD, off = wgid / NXCD; wgid = (xcd < r ? xcd * (q + 1) : r * (q + 1) + (xcd - r) * q) + off; }
        const int nig = WGM * nN, gid = wgid / nig, fm = gid * WGM, gsz = (nM - fm) < WGM ? (nM - fm) : WGM;
        u.pm = fm + ((wgid % nig) % gsz); u.pn = (wgid % nig) / gsz; return true;
    }
    __device__ __forceinline__ void a_ready(const Unit&) const {}
    __device__ __forceinline__ void done(const Unit&) const {}
};

template <class Epi, class Sched, bool ALIGN_EPI = false, bool SP2 = false>
__device__ __forceinline__ void gemm_phase(PG8_LAS unsigned char* lds, const Gemm g, const Sched& S, const Epi& E) {
    int tid_ = threadIdx.x; asm volatile("" : "+v"(tid_)); const int tid = tid_, wid = __builtin_amdgcn_readfirstlane(tid >> 6), lane = tid & 63, wr = wid >> 2, wc = wid & 3, fr = lane & 15, fq = lane >> 4;
    const int K = g.K, nt = K / BK;
    unsigned voffA[2], voffB[2];
#pragma unroll
    for (int i = 0; i < 2; ++i) { int R, C; stage_rc(tid * 16 + i * 8192, R, C); const int Rb = Epi::PERM ? ((R & ~31) + perm32(R & 31)) : R;
        voffA[i] = (unsigned)(R * K + C) * 2u; voffB[i] = (unsigned)(Rb * K + C) * 2u; }
    const size_t kstep = (size_t)(BK * 2);
    const size_t hstep = (size_t)HALF * K * 2;
    const size_t tstep = 2 * hstep;
    const unsigned ldsw = (unsigned)wid * 1024u;
    const int aoff = lds_byte(wr * 64 + fr, fq * 8), boff = lds_byte(wc * 32 + fr, fq * 8);
#define PG8_SA(b, h) (((b) * 2 + (h)) * HTB)
#define PG8_SB(b, h) ((4 + (b) * 2 + (h)) * HTB)
#define PG8_STAGE(bufoff, gbase, voff) do { _Pragma("unroll") for (int _i = 0; _i < 2; ++_i) \
        __builtin_amdgcn_global_load_lds((const unsigned*)((const char*)(gbase) + (voff)[_i]), (PG8_LAS unsigned*)(lds + (bufoff) + ldsw + _i * 8192), 16, 0, 0); } while (0)
#define PG8_LDA(dst, b, h) do { _Pragma("unroll") for (int m = 0; m < 4; ++m) _Pragma("unroll") for (int k = 0; k < 2; ++k) dst[m][k] = *(const PG8_LAS bf16x8*)(lds + PG8_SA(b, h) + aoff + m * 2048 + k * 1024); } while (0)
#define PG8_LDB(dst, b, h) do { _Pragma("unroll") for (int n = 0; n < 2; ++n) _Pragma("unroll") for (int k = 0; k < 2; ++k) dst[n][k] = *(const PG8_LAS bf16x8*)(lds + PG8_SB(b, h) + boff + n * 2048 + k * 1024); } while (0)
#define PG8_MMA(ai, bj, At, Bt) do { __builtin_amdgcn_s_setprio(1); _Pragma("unroll") for (int m = 0; m < 4; ++m) _Pragma("unroll") for (int n = 0; n < 2; ++n) _Pragma("unroll") for (int k = 0; k < 2; ++k) \
        acc[ai][bj][m][n] = __builtin_amdgcn_mfma_f32_16x16x32_bf16(Bt[n][k], At[m][k], acc[ai][bj][m][n], 0, 0, 0); __builtin_amdgcn_s_setprio(0); } while (0)
#define PG8_WAIT_V(n) asm volatile("s_waitcnt vmcnt(" #n ")" ::: "memory")
#define PG8_WAIT_L(n) asm volatile("s_waitcnt lgkmcnt(" #n ")" ::: "memory")
#define PG8_BAR __builtin_amdgcn_s_barrier()
#define PG8_SCHED __builtin_amdgcn_sched_barrier(0)
    Unit cur, nxt; int ui = 0;
    if (!S.next(0, cur)) return;
    f32x4 acc[2][2][4][2];
#pragma unroll
    for (int a = 0; a < 2; ++a)
#pragma unroll
        for (int b = 0; b < 2; ++b)
#pragma unroll
            for (int m = 0; m < 4; ++m)
#pragma unroll
                for (int n = 0; n < 2; ++n) acc[a][b][m][n] = (f32x4){0.f, 0.f, 0.f, 0.f};
    bf16x8 At[4][2], B0[2][2], B1[2][2];
    const char* cA = (const char*)g.A + (size_t)cur.pm * tstep; const char* cB = (const char*)g.Bt + (size_t)cur.pn * tstep;
    S.a_ready(cur);
    if constexpr (SP2) {
        PG8_STAGE(PG8_SB(0, 0), cB, voffB); PG8_STAGE(PG8_SB(0, 1), cB + hstep, voffB); PG8_STAGE(PG8_SA(0, 0), cA, voffA); PG8_STAGE(PG8_SA(0, 1), cA + hstep, voffA);
        if (wr == 1) PG8_BAR;
        PG8_WAIT_V(2); PG8_BAR;
        PG8_STAGE(PG8_SB(1, 0), cB + kstep, voffB); PG8_STAGE(PG8_SA(1, 0), cA + kstep, voffA); PG8_STAGE(PG8_SB(1, 1), cB + hstep + kstep, voffB);
        PG8_WAIT_V(6); PG8_BAR;
    } else {
        PG8_STAGE(PG8_SB(0, 0), cB, voffB); PG8_STAGE(PG8_SA(0, 0), cA, voffA); PG8_STAGE(PG8_SB(0, 1), cB + hstep, voffB); PG8_STAGE(PG8_SA(0, 1), cA + hstep, voffA);
        if (wr == 1) PG8_BAR;
        PG8_WAIT_V(4); PG8_BAR;
        PG8_STAGE(PG8_SB(1, 0), cB + kstep, voffB); PG8_STAGE(PG8_SA(1, 0), cA + kstep, voffA); PG8_STAGE(PG8_SB(1, 1), cB + hstep + kstep, voffB);
        PG8_WAIT_V(6); PG8_BAR;
    }
    for (;;) {
        const bool has_next = S.next(ui + 1, nxt);
        const char* nA = has_next ? (const char*)g.A + (size_t)nxt.pm * tstep : cA; const char* nB = has_next ? (const char*)g.Bt + (size_t)nxt.pn * tstep : cB;
        for (int t = 0; t < nt; t += 2) {
            const bool last = (t == nt - 2);
            const char* a1 = cA + (size_t)(t + 1) * kstep;
            const char* a2 = last ? nA : cA + (size_t)(t + 2) * kstep; const char* b2 = last ? nB : cB + (size_t)(t + 2) * kstep;
            const char* a3 = a2 + kstep; const char* b3 = b2 + kstep;
            if (last && has_next) S.a_ready(nxt);
            if constexpr (SP2) {
            PG8_LDB(B0, 0, 0); PG8_LDB(B1, 0, 1); PG8_SCHED; PG8_LDA(At, 0, 0); PG8_STAGE(PG8_SA(1, 1), a1 + hstep, voffA);
            PG8_WAIT_V(8); PG8_WAIT_L(0); PG8_BAR; PG8_MMA(0, 0, At, B0); PG8_MMA(0, 1, At, B1); PG8_BAR; PG8_SCHED;
            PG8_LDA(At, 0, 1); PG8_STAGE(PG8_SB(0, 0), b2, voffB); PG8_STAGE(PG8_SB(0, 1), b2 + hstep, voffB); PG8_STAGE(PG8_SA(0, 0), a2, voffA);
            PG8_WAIT_V(8); PG8_WAIT_L(0); PG8_BAR; PG8_MMA(1, 0, At, B0); PG8_MMA(1, 1, At, B1); PG8_BAR; PG8_SCHED;
            PG8_LDB(B0, 1, 0); PG8_LDB(B1, 1, 1); PG8_SCHED; PG8_LDA(At, 1, 0); PG8_STAGE(PG8_SA(0, 1), a2 + hstep, voffA);
            PG8_WAIT_V(8); PG8_WAIT_L(0); PG8_BAR; PG8_MMA(0, 0, At, B0); PG8_MMA(0, 1, At, B1); PG8_BAR; PG8_SCHED;
            PG8_LDA(At, 1, 1); PG8_STAGE(PG8_SB(1, 0), b3, voffB); PG8_STAGE(PG8_SB(1, 1), b3 + hstep, voffB); PG8_STAGE(PG8_SA(1, 0), a3, voffA);
            PG8_WAIT_V(8); PG8_WAIT_L(0); PG8_BAR; PG8_MMA(1, 0, At, B0); PG8_MMA(1, 1, At, B1); PG8_BAR; PG8_SCHED;
            } else {
            PG8_LDB(B0, 0, 0); PG8_SCHED; PG8_LDA(At, 0, 0); PG8_STAGE(PG8_SA(1, 1), a1 + hstep, voffA);
            PG8_WAIT_L(8); PG8_BAR; PG8_WAIT_L(0); PG8_MMA(0, 0, At, B0); PG8_BAR; PG8_SCHED;
            PG8_LDB(B1, 0, 1); PG8_STAGE(PG8_SB(0, 0), b2, voffB);
            PG8_BAR; PG8_WAIT_L(0); PG8_MMA(0, 1, At, B1); PG8_BAR;
            PG8_LDA(At, 0, 1); PG8_STAGE(PG8_SA(0, 0), a2, voffA);
            PG8_BAR; PG8_WAIT_L(0); PG8_MMA(1, 0, At, B0); PG8_BAR; PG8_SCHED;
            PG8_STAGE(PG8_SB(0, 1), b2 + hstep, voffB);
            PG8_WAIT_V(6); PG8_BAR; PG8_MMA(1, 1, At, B1); PG8_BAR;
            PG8_LDB(B0, 1, 0); PG8_SCHED; PG8_LDA(At, 1, 0); PG8_STAGE(PG8_SA(0, 1), a2 + hstep, voffA);
            PG8_WAIT_L(8); PG8_BAR; PG8_WAIT_L(0); PG8_MMA(0, 0, At, B0); PG8_BAR; PG8_SCHED;
            PG8_LDB(B1, 1, 1); PG8_STAGE(PG8_SB(1, 0), b3, voffB);
            PG8_BAR; PG8_WAIT_L(0); PG8_MMA(0, 1, At, B1); PG8_BAR;
            PG8_LDA(At, 1, 1); PG8_STAGE(PG8_SA(1, 0), a3, voffA);
            PG8_BAR; PG8_WAIT_L(0); PG8_MMA(1, 0, At, B0); PG8_BAR; PG8_SCHED;
            PG8_STAGE(PG8_SB(1, 1), b3 + hstep, voffB);
            PG8_WAIT_V(6); PG8_BAR; PG8_MMA(1, 1, At, B1); PG8_BAR;
            }
        }
        if constexpr (ALIGN_EPI) { if (wr == 0) PG8_BAR; }
        if constexpr (!Epi::AFTER_DRAIN) { E(acc, cur, wr, wc, fr, fq); S.done(cur); }
        if (!has_next) break;
#pragma unroll
        for (int a = 0; a < 2; ++a)
#pragma unroll
            for (int b = 0; b < 2; ++b)
#pragma unroll
                for (int m = 0; m < 4; ++m)
#pragma unroll
                    for (int n = 0; n < 2; ++n) acc[a][b][m][n] = (f32x4){0.f, 0.f, 0.f, 0.f};
        cur = nxt; cA = nA; cB = nB; ++ui;
        if constexpr (ALIGN_EPI) { if (wr == 1) PG8_BAR; }
    }
    PG8_WAIT_V(0);
    if constexpr (!ALIGN_EPI) { if (wr == 0) PG8_BAR; }
    PG8_BAR;
    if constexpr (Epi::AFTER_DRAIN) { E.fused(acc, cur, wr, wc, fr, fq, lds, wid, lane); S.done(cur); }
#undef PG8_SA
#undef PG8_SB
#undef PG8_STAGE
#undef PG8_LDA
#undef PG8_LDB
#undef PG8_MMA
#undef PG8_WAIT_V
#undef PG8_WAIT_L
#undef PG8_BAR
#undef PG8_SCHED
}
}

typedef pg8::Unit Unit;
#define EPI8 _Pragma("unroll") for (int ai = 0; ai < 2; ++ai) _Pragma("unroll") for (int m = 0; m < 4; ++m) _Pragma("unroll") for (int bj = 0; bj < 2; ++bj)
#define EROW (u.pm * 256 + ai * 128 + wr * 64 + m * 16 + fr)
#define ECOL (u.pn * 256 + bj * 128 + wc * 32 + 8 * fq)
DI u32x4 pk8(f32x4 a, f32x4 b) { u32x4 o; o.x = pack2(a[0], a[1]); o.y = pack2(a[2], a[3]); o.z = pack2(b[0], b[1]); o.w = pack2(b[2], b[3]); return o; }

#define EOFF(ld) ((unsigned)EROW * (unsigned)(ld) + (unsigned)ECOL)
#define ESB __builtin_amdgcn_sched_barrier(0)
struct EpiH0 {
    static constexpr bool PERM = true, AFTER_DRAIN = false;
    u16* H; const float* lbl;
    DI void operator()(const f32x4 (&acc)[2][2][4][2], const Unit& u, int wr, int wc, int fr, int fq) const {
        const int region = (u.pn * 256) >> 9;
        EPI8 {
            const unsigned col = ECOL;
            f32x4 v0 = acc[ai][bj][m][0], v1 = acc[ai][bj][m][1];
            if (region <= 1) { _Pragma("unroll") for (int r = 0; r < 4; ++r) { v0[r] = gelu_tanh(v0[r]); v1[r] = gelu_tanh(v1[r]); } }
            else if (region == 3) {
                const f32x4 a0 = *(const f32x4*)(lbl + (col - 1536u)), a1 = *(const f32x4*)(lbl + (col - 1536u + 4u)), b0 = *(const f32x4*)(lbl + (col - 1024u)), b1 = *(const f32x4*)(lbl + (col - 1024u + 4u));
                _Pragma("unroll") for (int r = 0; r < 4; ++r) {
                    const float lb0 = 1.f / (1.f + __expf(b0[r] - a0[r])), lb1 = 1.f / (1.f + __expf(b1[r] - a1[r]));
                    v0[r] = __logf(lb0 + (1.f - lb0) * sigmoidf(v0[r])); v1[r] = __logf(lb1 + (1.f - lb1) * sigmoidf(v1[r]));
                }
            }
            else if (region >= 4) { _Pragma("unroll") for (int r = 0; r < 4; ++r) { v0[r] = siluf(v0[r]); v1[r] = siluf(v1[r]); } }
            *(u32x4*)(H + EOFF(3072)) = pk8(v0, v1);
            ESB;
        }
    }
};
struct EpiSplit {
    static constexpr bool PERM = true, AFTER_DRAIN = false;
    u16* d0; u16* d1; u16* d2; u16* d3; float scale0;
    DI void operator()(const f32x4 (&acc)[2][2][4][2], const Unit& u, int wr, int wc, int fr, int fq) const {
        const int reg = (u.pn * 256) >> 10;
        u16* D = reg == 0 ? d0 : (reg == 1 ? d1 : (reg == 2 ? d2 : d3));
        const float sc = reg == 0 ? scale0 : 1.f;
        EPI8 { *(u32x4*)(D + ((unsigned)EROW * 1024u + ((unsigned)ECOL & 1023u))) = pk8(acc[ai][bj][m][0] * sc, acc[ai][bj][m][1] * sc); ESB; }
    }
};
struct EpiZ {
    static constexpr bool PERM = true, AFTER_DRAIN = false;
    const float* res; float* out;
    DI void operator()(const f32x4 (&acc)[2][2][4][2], const Unit& u, int wr, int wc, int fr, int fq) const {
        EPI8 { const unsigned o = EOFF(1024);
            const f32x4 r0 = *(const f32x4*)(res + o), r1 = *(const f32x4*)(res + o + 4u);
            *(f32x4*)(out + o) = r0 * ALPHA + acc[ai][bj][m][0];
            *(f32x4*)(out + o + 4u) = r1 * ALPHA + acc[ai][bj][m][1]; ESB; }
    }
};
struct EpiFFN {
    static constexpr bool PERM = true, AFTER_DRAIN = false;
    u16* Hd;
    DI void operator()(const f32x4 (&acc)[2][2][4][2], const Unit& u, int wr, int wc, int fr, int fq) const {
#pragma unroll
        for (int ai = 0; ai < 2; ++ai)
#pragma unroll
            for (int m = 0; m < 4; ++m) {
                f32x4 v0, v1;
#pragma unroll
                for (int r = 0; r < 4; ++r) { v0[r] = siluf(acc[ai][0][m][0][r]) * acc[ai][1][m][0][r]; v1[r] = siluf(acc[ai][0][m][1][r]) * acc[ai][1][m][1][r]; }
                *(u32x4*)(Hd + ((unsigned)EROW * (unsigned)DFF + (unsigned)(u.pn * 128 + wc * 32 + 8 * fq))) = pk8(v0, v1);
                ESB;
            }
    }
};
template <class Epi>
DI void run_gemm(char* lds, const u16* A, const u16* Bt, int M, int N, int K, const Epi& epi) {
    pg8::Gemm g; g.A = A; g.Bt = Bt; g.M = M; g.N = N; g.K = K;
    pg8::StaticOrder so; so.init(M, N, gridDim.x, blockIdx.x);
    pg8::gemm_phase<Epi, pg8::StaticOrder, true, true>((PG8_LAS unsigned char*)lds, g, so, epi);
}

DI void transpose_item(const float* __restrict__ W, int K, int N, u16* __restrict__ WT, int perm, int item, float* scr) {
    const int ntn = N >> 6, kb = item / ntn, nb = item % ntn, k0 = kb * 64, n0 = nb * 64, tid = get_tid();
    __syncthreads();
#pragma unroll
    for (int i = 0; i < 16; ++i) { const int kk = i * 4 + (tid >> 6), nn = tid & 63; scr[kk * 65 + nn] = W[(size_t)(k0 + kk) * N + n0 + nn]; }
    __syncthreads();
    const int n = tid >> 2, c = tid & 3;
    const float* s = scr + (c * 16) * 65 + n;
    u32x4 o0, o1;
    o0.x = pack2(s[0 * 65], s[1 * 65]); o0.y = pack2(s[2 * 65], s[3 * 65]); o0.z = pack2(s[4 * 65], s[5 * 65]); o0.w = pack2(s[6 * 65], s[7 * 65]);
    o1.x = pack2(s[8 * 65], s[9 * 65]); o1.y = pack2(s[10 * 65], s[11 * 65]); o1.z = pack2(s[12 * 65], s[13 * 65]); o1.w = pack2(s[14 * 65], s[15 * 65]);
    int nsrc = n0 + n, drow = nsrc;
    if (perm) { if (nsrc < DFF) drow = (nsrc >> 7) * 256 + (nsrc & 127); else { const int n2 = nsrc - DFF; drow = (n2 >> 7) * 256 + 128 + (n2 & 127); } }
    u32x4* dst = (u32x4*)(WT + (size_t)drow * K + k0 + c * 16);
    dst[0] = o0; dst[1] = o1;
}

DI void phase_prep(const Params& p, char* lds, int vbid, int nvb) {
    float* scr = (float*)lds;
    char* ws = p.ws;
    constexpr int T1 = 16 * 48, TS = 16 * 16, TKV = 16 * 32, TFI = 16 * 88, TFO = 44 * 16;
    constexpr int NTR = T1 + TS + 2 * TS + 2 * TKV + 2 * TS + 2 * TFI + 2 * TFO + T1 + TS;
    constexpr int NXC = NT * DM / 2048, NMC = 2048 * DM / 2048;
    for (int it = vbid; it < NTR + NXC + NMC; it += nvb) {
        int r = it;
        if (r < NTR) {
            if (r < T1) { transpose_item(p.in[9], 1024, 3072, (u16*)(ws + O_WT_EVIN), 0, r, scr); continue; } r -= T1;
            if (r < TS) { transpose_item(p.in[10], 1024, 1024, (u16*)(ws + O_WT_EVOUT), 0, r, scr); continue; } r -= TS;
            if (r < 2 * TS) { const int l = r / TS; transpose_item(p.in[4] + (size_t)l * 1024 * 1024, 1024, 1024, (u16*)(ws + O_WT_WQ + l * 2 * MB), 0, r % TS, scr); continue; } r -= 2 * TS;
            if (r < 2 * TKV) { const int l = r / TKV; transpose_item(p.in[5] + (size_t)l * 1024 * 2048, 1024, 2048, (u16*)(ws + O_WT_WKV + l * 4 * MB), 0, r % TKV, scr); continue; } r -= 2 * TKV;
            if (r < 2 * TS) { const int l = r / TS; transpose_item(p.in[6] + (size_t)l * 1024 * 1024, 1024, 1024, (u16*)(ws + O_WT_WO + l * 2 * MB), 0, r % TS, scr); continue; } r -= 2 * TS;
            if (r < 2 * TFI) { const int l = r / TFI; transpose_item(p.in[7] + (size_t)l * 1024 * 5632, 1024, 5632, (u16*)(ws + O_WT_FIN + l * 11 * MB), 1, r % TFI, scr); continue; } r -= 2 * TFI;
            if (r < 2 * TFO) { const int l = r / TFO; transpose_item(p.in[8] + (size_t)l * 2816 * 1024, 2816, 1024, (u16*)(ws + O_WT_FOUT + l * (11 * MB / 2)), 0, r % TFO, scr); continue; } r -= 2 * TFO;
            if (r < T1) { transpose_item(p.in[17], 1024, 3072, (u16*)(ws + O_WT_QKV), 0, r, scr); continue; } r -= T1;
            transpose_item(p.in[18], 1024, 1024, (u16*)(ws + O_WT_ODOUT), 0, r, scr);
            continue;
        }
        r -= NTR;
        const float* src; u16* dst;
        if (r < NXC) { src = p.in[0]; dst = (u16*)(ws + O_XB); } else { r -= NXC; src = p.in[1]; dst = (u16*)(ws + O_MEMB); }
        const size_t e = (size_t)r * 2048 + get_tid() * 8;
        const f32x4 a = *(const f32x4*)(src + e), b = *(const f32x4*)(src + e + 4);
        u32x4 o; o.x = pack2(a[0], a[1]); o.y = pack2(a[2], a[3]); o.z = pack2(b[0], b[1]); o.w = pack2(b[2], b[3]);
        *(u32x4*)(dst + e) = o;
    }
}

DI void phase_ln(const float* __restrict__ g, const float* __restrict__ bta, float* xio, u16* xb) {
    const int tid8 = get_tid8(), lane = tid8 & 63, gw = blockIdx.x * 8 + (tid8 >> 6), nw = gridDim.x * 8;
    for (int row = gw; row < NT; row += nw) {
        f32x4* xr = (f32x4*)(xio + (size_t)row * 1024);
        f32x4 v[4]; float s = 0.f;
#pragma unroll
        for (int j = 0; j < 4; ++j) { v[j] = xr[lane + 64 * j]; s += (v[j][0] + v[j][1]) + (v[j][2] + v[j][3]); }
#pragma unroll
        for (int o = 1; o < 64; o <<= 1) s += __shfl_xor(s, o);
        const float mean = s * (1.f / 1024.f); float q = 0.f;
#pragma unroll
        for (int j = 0; j < 4; ++j) { v[j] = v[j] - mean; q += (v[j][0] * v[j][0] + v[j][1] * v[j][1]) + (v[j][2] * v[j][2] + v[j][3] * v[j][3]); }
#pragma unroll
        for (int o = 1; o < 64; o <<= 1) q += __shfl_xor(q, o);
        const float rstd = rsqrtf(q * (1.f / 1024.f) + LN_EPS);
#pragma unroll
        for (int j = 0; j < 4; ++j) {
            const f32x4 gg = ((const f32x4*)g)[lane + 64 * j], bb = ((const f32x4*)bta)[lane + 64 * j];
            const f32x4 y = v[j] * rstd * gg + bb;
            xr[lane + 64 * j] = y;
            u32x2 o; o.x = pack2(y[0], y[1]); o.y = pack2(y[2], y[3]);
            ((u32x2*)(xb + (size_t)row * 1024))[lane + 64 * j] = o;
        }
    }
}

DI void gmlp_item(const Params& p, int item, char* lds) {
    const int tid = get_tid(), lane = tid & 63, w = tid >> 6, wr = w >> 1, wc = w & 1, fr = lane & 15, fq = lane >> 4;
    const int g = item & 3, n = (item >> 2) & 15, b = item >> 6;
    const u16* H = (const u16*)(p.ws + O_H);
    u16* YM = (u16*)(p.ws + O_YM);
    u16* sW = (u16*)lds; u16* sV = sW + 128 * 136;
    const size_t row_base = (size_t)b * SEQ + n * 128;
    __syncthreads();
    {
        const float* Wg = p.in[11] + (size_t)g * 128 * 128;
#pragma unroll 4
        for (int c = tid; c < 128 * 32; c += 256) {
            const int t = c >> 5, s4 = (c & 31) * 4;
            const f32x4 v = *(const f32x4*)(Wg + t * 128 + s4);
            u32x2 o; o.x = pack2(s4 + 0 <= t ? v[0] : 0.f, s4 + 1 <= t ? v[1] : 0.f); o.y = pack2(s4 + 2 <= t ? v[2] : 0.f, s4 + 3 <= t ? v[3] : 0.f);
            *(u32x2*)(sW + t * 136 + s4) = o;
        }
    }
    {
        const int r = tid >> 1, half = tid & 1;
        const u16* src = H + (row_base + r) * 3072 + 512 + g * 128 + half * 64;
        float x[64]; float s = 0.f;
#pragma unroll
        for (int j = 0; j < 8; ++j) {
            const u32x4 q = *(const u32x4*)(src + j * 8);
#pragma unroll
            for (int e = 0; e < 4; ++e) { x[j * 8 + 2 * e] = __uint_as_float(q[e] << 16); x[j * 8 + 2 * e + 1] = __uint_as_float(q[e] & 0xffff0000u); }
        }
#pragma unroll
        for (int j = 0; j < 64; ++j) s += x[j];
        s += __shfl_xor(s, 1);
        const float mean = s * (1.f / 128.f); float q2 = 0.f;
#pragma unroll
        for (int j = 0; j < 64; ++j) { x[j] -= mean; q2 += x[j] * x[j]; }
        q2 += __shfl_xor(q2, 1);
        const float rstd = rsqrtf(q2 * (1.f / 128.f) + LN_EPS);
        const float* lg = p.in[13] + g * 128 + half * 64; const float* lb = p.in[14] + g * 128 + half * 64;
#pragma unroll
        for (int j = 0; j < 64; ++j) sV[(half * 64 + j) * 136 + r] = f2bf(x[j] * rstd * lg[j] + lb[j]);
    }
    __syncthreads();
    f32x4 acc[4][4];
#pragma unroll
    for (int i = 0; i < 4; ++i)
#pragma unroll
        for (int j = 0; j < 4; ++j) acc[i][j] = (f32x4){0.f, 0.f, 0.f, 0.f};
    const u16* cA = sW + (wr * 64 + fr) * 136 + fq * 8;
    const u16* cB = sV + (wc * 64 + fr) * 136 + fq * 8;
#pragma unroll
    for (int ks = 0; ks < 4; ++ks) {
        bf16x8 a[4], bb[4];
#pragma unroll
        for (int i = 0; i < 4; ++i) { a[i] = *(const bf16x8*)(cA + i * 16 * 136 + ks * 32); bb[i] = *(const bf16x8*)(cB + i * 16 * 136 + ks * 32); }
#pragma unroll
        for (int i = 0; i < 4; ++i)
#pragma unroll
            for (int j = 0; j < 4; ++j) acc[i][j] = mfma16(a[i], bb[j], acc[i][j]);
    }
    const float* bs = p.in[12] + g * 128;
#pragma unroll
    for (int mi = 0; mi < 4; ++mi)
#pragma unroll
        for (int i = 0; i < 4; ++i) {
            const int t = wr * 64 + mi * 16 + fq * 4 + i; const float bt = bs[t];
#pragma unroll
            for (int ni = 0; ni < 4; ++ni) {
                const int c = wc * 64 + ni * 16 + fr;
                const float u = bf2f(H[(row_base + t) * 3072 + g * 128 + c]);
                YM[(row_base + t) * 1024 + g * 128 + c] = f2bf(u * (acc[mi][ni][i] + bt));
            }
        }
}

template <int ROWS, int COLS, int LD>
DI void stage_tile(u16* s, const u16* g, int ld) {
    constexpr int CPR = COLS / 8, TOT = ROWS * CPR;
    const int tid = get_tid();
#pragma unroll
    for (int c0 = 0; c0 < TOT; c0 += 256) { const int c = c0 + tid, r = c / CPR, cc = (c % CPR) * 8; *(u32x4*)(s + r * LD + cc) = *(const u32x4*)(g + (size_t)r * ld + cc); }
}

DI void hgrn_prep_cum(const u16* src, int th, int ch, float* sTot, float (&cum)[32], float& total) {
    float run = 0.f;
#pragma unroll
    for (int j = 0; j < 32; ++j) { run += bf2f(src[(size_t)j * 3072 + 1536]); cum[j] = run; }
    sTot[th * 128 + ch] = run;
    __syncthreads();
    const float t0 = sTot[ch], t1 = sTot[128 + ch], off = th ? t0 : 0.f;
    total = t0 + t1;
#pragma unroll
    for (int j = 0; j < 32; ++j) cum[j] += off;
}

DI void hgrnA_item(const Params& p, int item, char* lds) {
    const int tid = get_tid(), lane = tid & 63, w = tid >> 6, fr = lane & 15, fq = lane >> 4;
    const int n = item & 31, bh = item >> 5, h = bh & 3, b = bh >> 2;
    const u16* H = (const u16*)(p.ws + O_H);
    u16* YM = (u16*)(p.ws + O_YM);
    float* U = p.out + (size_t)item * 16384;
    float* DEC = (float*)(p.ws + O_KM + 512 * 1024) + (size_t)item * 128;
    u16* sQ = (u16*)lds;
    u16* sKd = sQ + 64 * 136;
    u16* sKt = sKd + 64 * 136;
    u16* sI = sKt + 128 * 72;
    float* sTot = (float*)(sI + 128 * 72);
    u16* sAt = sKd;
    const int ch = tid & 127, th = tid >> 7;
    const size_t row_base = (size_t)b * SEQ + n * 64;
    __syncthreads();
    {
        const u16* src = H + (row_base + th * 32) * 3072 + h * 128 + ch;
        float cum[32]; float total;
        hgrn_prep_cum(src, th, ch, sTot, cum, total);
        if (th == 0) DEC[ch] = __expf(total);
        float prev = th ? sTot[ch] : 0.f;
#pragma unroll
        for (int j8 = 0; j8 < 4; ++j8) {
            unsigned kt[4], iv[4];
#pragma unroll
            for (int jj = 0; jj < 8; ++jj) {
                const int j = j8 * 8 + jj;
                const float c = cum[j], lf = c - prev; prev = c;
                const float q = bf2f(src[(size_t)j * 3072 + 1024]);
                const unsigned ivv = src[(size_t)j * 3072 + 2048];
                const float kc = 1.f - __expf(lf);
                sQ[(th * 32 + j) * 136 + ch] = f2bf(q * __expf(c));
                sKd[(th * 32 + j) * 136 + ch] = f2bf(kc * __expf(-c));
                const unsigned ktv = f2bf(kc * __expf(total - c));
                if (jj & 1) { kt[jj >> 1] |= ktv << 16; iv[jj >> 1] |= ivv << 16; } else { kt[jj >> 1] = ktv; iv[jj >> 1] = ivv; }
            }
            *(u32x4*)(sKt + ch * 72 + th * 32 + j8 * 8) = (u32x4){kt[0], kt[1], kt[2], kt[3]};
            *(u32x4*)(sI + ch * 72 + th * 32 + j8 * 8) = (u32x4){iv[0], iv[1], iv[2], iv[3]};
        }
    }
    __syncthreads();
    f32x4 at[4];
#pragma unroll
    for (int nt = 0; nt < 4; ++nt) at[nt] = (f32x4){0.f, 0.f, 0.f, 0.f};
#pragma unroll
    for (int ks = 0; ks < 4; ++ks) {
        const bf16x8 a = *(const bf16x8*)(sQ + (16 * w + fr) * 136 + ks * 32 + fq * 8);
#pragma unroll
        for (int nt = 0; nt < 4; ++nt) { const bf16x8 bb = *(const bf16x8*)(sKd + (nt * 16 + fr) * 136 + ks * 32 + fq * 8); at[nt] = mfma16(a, bb, at[nt]); }
    }
    __syncthreads();
#pragma unroll
    for (int nt = 0; nt < 4; ++nt)
#pragma unroll
        for (int i = 0; i < 4; ++i) { const int t = 16 * w + fq * 4 + i, s = nt * 16 + fr; sAt[t * 72 + s] = f2bf(s <= t ? at[nt][i] : 0.f); }
    __syncthreads();
    {
        f32x4 oacc[4][2];
#pragma unroll
        for (int mt = 0; mt < 4; ++mt) { oacc[mt][0] = (f32x4){0.f, 0.f, 0.f, 0.f}; oacc[mt][1] = (f32x4){0.f, 0.f, 0.f, 0.f}; }
#pragma unroll
        for (int ks = 0; ks < 2; ++ks) {
            bf16x8 bb[2];
#pragma unroll
            for (int nt = 0; nt < 2; ++nt) bb[nt] = *(const bf16x8*)(sI + (32 * w + nt * 16 + fr) * 72 + ks * 32 + fq * 8);
#pragma unroll
            for (int mt = 0; mt < 4; ++mt) {
                const bf16x8 a = *(const bf16x8*)(sAt + (mt * 16 + fr) * 72 + ks * 32 + fq * 8);
                oacc[mt][0] = mfma16(a, bb[0], oacc[mt][0]); oacc[mt][1] = mfma16(a, bb[1], oacc[mt][1]);
            }
        }
#pragma unroll
        for (int mt = 0; mt < 4; ++mt)
#pragma unroll
            for (int nt = 0; nt < 2; ++nt)
#pragma unroll
                for (int i = 0; i < 4; ++i)
                    YM[(row_base + mt * 16 + fq * 4 + i) * 1024 + 512 + h * 128 + 32 * w + nt * 16 + fr] = f2bf(oacc[mt][nt][i]);
    }
    {
        f32x4 u[2][8];
#pragma unroll
        for (int mt = 0; mt < 2; ++mt)
#pragma unroll
            for (int nt = 0; nt < 8; ++nt) u[mt][nt] = (f32x4){0.f, 0.f, 0.f, 0.f};
#pragma unroll
        for (int ks = 0; ks < 2; ++ks) {
            bf16x8 a[2];
#pragma unroll
            for (int mt = 0; mt < 2; ++mt) a[mt] = *(const bf16x8*)(sI + (32 * w + mt * 16 + fr) * 72 + ks * 32 + fq * 8);
#pragma unroll
            for (int nt = 0; nt < 8; ++nt) {
                const bf16x8 bb = *(const bf16x8*)(sKt + (nt * 16 + fr) * 72 + ks * 32 + fq * 8);
                u[0][nt] = mfma16(a[0], bb, u[0][nt]); u[1][nt] = mfma16(a[1], bb, u[1][nt]);
            }
        }
#pragma unroll
        for (int mt = 0; mt < 2; ++mt)
#pragma unroll
            for (int nt = 0; nt < 8; ++nt)
#pragma unroll
                for (int i = 0; i < 4; ++i) U[(32 * w + mt * 16 + fq * 4 + i) * 128 + nt * 16 + fr] = u[mt][nt][i];
    }
}

DI void hgrn_scan(const Params& p) {
    const int tid = get_tid8();
    const float* U = p.out;
    const float* DEC = (const float*)(p.ws + O_KM + 512 * 1024);
    u16* ST = (u16*)(p.ws + O_XB);
    for (int idx = blockIdx.x * 512 + tid; idx < 32 * 4096; idx += gridDim.x * 512) {
        const int bh = idx >> 12, e4 = (idx & 4095) * 4, k = e4 & 127;
        f32x4 s = (f32x4){0.f, 0.f, 0.f, 0.f};
#pragma unroll 8
        for (int n = 0; n < 32; ++n) {
            const size_t item = (size_t)bh * 32 + n;
            const f32x4 u = *(const f32x4*)(U + item * 16384 + e4);
            const f32x4 d = *(const f32x4*)(DEC + item * 128 + k);
            u32x2 o; o.x = pack2(s[0], s[1]); o.y = pack2(s[2], s[3]);
            *(u32x2*)(ST + item * 16384 + e4) = o;
            s = d * s + u;
        }
    }
}

DI void hgrnC_item(const Params& p, int item, char* lds) {
    const int tid = get_tid(), lane = tid & 63, w = tid >> 6, fr = lane & 15, fq = lane >> 4;
    const int n = item & 31, bh = item >> 5, h = bh & 3, b = bh >> 2;
    const u16* H = (const u16*)(p.ws + O_H);
    u16* YM = (u16*)(p.ws + O_YM);
    const u16* ST = (const u16*)(p.ws + O_XB) + (size_t)item * 16384;
    u16* sQ = (u16*)lds;
    u16* sS = sQ + 64 * 136;
    float* sTot = (float*)(sS + 128 * 136);
    float* sSsq = sTot + 256;
    const float* gn = p.in[15] + h * 128;
    const int ch = tid & 127, th = tid >> 7;
    const size_t row_base = (size_t)b * SEQ + n * 64;
    __syncthreads();
    stage_tile<128, 128, 136>(sS, ST, 128);
    {
        const u16* src = H + (row_base + th * 32) * 3072 + h * 128 + ch;
        float cum[32]; float total;
        hgrn_prep_cum(src, th, ch, sTot, cum, total);
#pragma unroll
        for (int j = 0; j < 32; ++j) sQ[(th * 32 + j) * 136 + ch] = f2bf(bf2f(src[(size_t)j * 3072 + 1024]) * __expf(cum[j]));
    }
    __syncthreads();
    f32x4 oacc[4][2];
#pragma unroll
    for (int mt = 0; mt < 4; ++mt) { oacc[mt][0] = (f32x4){0.f, 0.f, 0.f, 0.f}; oacc[mt][1] = (f32x4){0.f, 0.f, 0.f, 0.f}; }
#pragma unroll
    for (int ks = 0; ks < 4; ++ks) {
        bf16x8 bb[2];
#pragma unroll
        for (int nt = 0; nt < 2; ++nt) bb[nt] = *(const bf16x8*)(sS + (32 * w + nt * 16 + fr) * 136 + ks * 32 + fq * 8);
#pragma unroll
        for (int mt = 0; mt < 4; ++mt) {
            const bf16x8 a = *(const bf16x8*)(sQ + (mt * 16 + fr) * 136 + ks * 32 + fq * 8);
            oacc[mt][0] = mfma16(a, bb[0], oacc[mt][0]); oacc[mt][1] = mfma16(a, bb[1], oacc[mt][1]);
        }
    }
#pragma unroll
    for (int mt = 0; mt < 4; ++mt)
#pragma unroll
        for (int i = 0; i < 4; ++i) {
#pragma unroll
            for (int nt = 0; nt < 2; ++nt) oacc[mt][nt][i] += bf2f(YM[(row_base + mt * 16 + fq * 4 + i) * 1024 + 512 + h * 128 + 32 * w + nt * 16 + fr]);
            float q = oacc[mt][0][i] * oacc[mt][0][i] + oacc[mt][1][i] * oacc[mt][1][i];
            q += __shfl_xor(q, 1); q += __shfl_xor(q, 2); q += __shfl_xor(q, 4); q += __shfl_xor(q, 8);
            if (fr == 0) sSsq[w * 64 + mt * 16 + fq * 4 + i] = q;
        }
    __syncthreads();
#pragma unroll
    for (int mt = 0; mt < 4; ++mt)
#pragma unroll
        for (int i = 0; i < 4; ++i) {
            const int t = mt * 16 + fq * 4 + i;
            const float tot = (sSsq[t] + sSsq[64 + t]) + (sSsq[128 + t] + sSsq[192 + t]);
            const float r = rsqrtf(tot * (1.f / 128.f) + LN_EPS);
#pragma unroll
            for (int nt = 0; nt < 2; ++nt) {
                const int v = 32 * w + nt * 16 + fr;
                const float gate = bf2f(H[(row_base + t) * 3072 + 2560 + h * 128 + v]);
                YM[(row_base + t) * 1024 + 512 + h * 128 + v] = f2bf(oacc[mt][nt][i] * r * gn[v] * gate);
            }
        }
}

DI void chunk_load(u32x4 (&r)[4], const u16* g, int ld, bool vtype, int tid) {
#pragma unroll
    for (int i = 0; i < 4; ++i) { const int c = tid + i * 256; const int row = vtype ? (c >> 4) : (c >> 3), cc = vtype ? ((c & 15) * 8) : ((c & 7) * 8); r[i] = *(const u32x4*)(g + (size_t)row * ld + cc); }
}
DI void chunk_store(const u32x4 (&r)[4], u16* s, bool vtype, int tid) {
#pragma unroll
    for (int i = 0; i < 4; ++i) { const int c = tid + i * 256; const int row = vtype ? (c >> 4) : (c >> 3), cc = vtype ? ((c & 15) * 8) : ((c & 7) * 8); *(u32x4*)(s + row * (vtype ? 136 : 72) + cc) = r[i]; }
}
DI void attn_qk(f32x4 (&sacc)[8], const u16* sK, bf16x8 b0, bf16x8 b1, int fr, int fq) {
#pragma unroll
    for (int mt = 0; mt < 8; ++mt) {
        const u16* a = sK + (mt * 16 + fr) * 72 + fq * 8;
        sacc[mt] = mfma16(*(const bf16x8*)a, b0, sacc[mt]);
        sacc[mt] = mfma16(*(const bf16x8*)(a + 32), b1, sacc[mt]);
    }
}
template <int NO, int OFF>
DI void attn_pv(f32x4 (&oacc)[NO], const u16* sV, const bf16x8 (&pb)[4], int fr, int fq) {
#pragma unroll
    for (int s = 0; s < 4; ++s)
#pragma unroll
        for (int mt = 0; mt < 4; ++mt) {
            const u16* va = sV + (mt * 16 + fr) * 136 + 32 * s + fq * 4;
            oacc[OFF + mt] = mfma16(mk8(*(const u32x2*)va, *(const u32x2*)(va + 16)), pb[s], oacc[OFF + mt]);
        }
}
template <int NO>
DI void attn_softmax(f32x4 (&sacc)[8], f32x4 (&oacc)[NO], float& m, float& l, bf16x8 (&pb)[4]) {
    float mx = -1e30f;
#pragma unroll
    for (int mt = 0; mt < 8; ++mt) mx = fmaxf(fmaxf(mx, fmaxf(sacc[mt][0], sacc[mt][1])), fmaxf(sacc[mt][2], sacc[mt][3]));
    mx = fmaxf(mx, __shfl_xor(mx, 16)); mx = fmaxf(mx, __shfl_xor(mx, 32));
    const float mnew = fmaxf(m, mx), corr = __builtin_amdgcn_exp2f(m - mnew);
    l *= corr;
#pragma unroll
    for (int i = 0; i < NO; ++i) oacc[i] = oacc[i] * corr;
    float ps = 0.f;
#pragma unroll
    for (int mt = 0; mt < 8; ++mt)
#pragma unroll
        for (int i = 0; i < 4; ++i) { const float pe = __builtin_amdgcn_exp2f(sacc[mt][i] - mnew); ps += pe; sacc[mt][i] = pe; }
    l += ps; m = mnew;
#pragma unroll
    for (int s = 0; s < 4; ++s) pb[s] = pack8(sacc[2 * s], sacc[2 * s + 1]);
}

DI void cross_item(const Params& p, int l, int item, char* lds) {
    const int tid = get_tid(), lane = tid & 63, w = tid >> 6, fr = lane & 15, fq = lane >> 4;
    const int qt = item & 31, h = (item >> 5) & 3, b = item >> 7;
    const u16* Q = (const u16*)(p.ws + O_H);
    const u16* Kd = (const u16*)(p.ws + O_KVK + l * 4 * MB) + ((size_t)b * 256) * 1024 + h * 256;
    const u16* Vt = (const u16*)(p.ws + O_KVV + l * 4 * MB) + ((size_t)(b * 4 + h) * 256) * 256;
    u16* O = (u16*)(p.ws + O_YM);
    u16* sbuf = (u16*)lds;
    const size_t qrow = (size_t)b * SEQ + qt * 64 + w * 16 + fr;
    u16* sQ = sbuf + 2 * 9216 + w * (16 * 264);
    __syncthreads();
#pragma unroll
    for (int i = 0; i < 8; ++i) *(u32x4*)(sQ + fr * 264 + i * 32 + fq * 8) = *(const u32x4*)(Q + qrow * 1024 + h * 256 + i * 32 + fq * 8);
    f32x4 oacc[16];
#pragma unroll
    for (int i = 0; i < 16; ++i) oacc[i] = (f32x4){0.f, 0.f, 0.f, 0.f};
    float m = -1e30f, lsum = 0.f;
    f32x4 sacc[8]; bf16x8 pb[4];
    u32x4 rg[4];
    chunk_load(rg, Kd, 1024, false, tid);
    chunk_store(rg, sbuf, false, tid);
    __syncthreads();
    for (int kt = 0; kt < 2; ++kt) {
#pragma unroll
        for (int j = 0; j < 8; ++j) {
            if (j < 3) chunk_load(rg, Kd + (size_t)kt * 128 * 1024 + (j + 1) * 64, 1024, false, tid);
            else if (j < 7) chunk_load(rg, Vt + (size_t)(j - 3) * 64 * 256 + kt * 128, 256, true, tid);
            else if (kt == 0) chunk_load(rg, Kd + (size_t)128 * 1024, 1024, false, tid);
            const u16* sb = sbuf + (j & 1) * 9216;
            if (j < 4) {
                if (j == 0) {
#pragma unroll
                    for (int i = 0; i < 8; ++i) sacc[i] = (f32x4){0.f, 0.f, 0.f, 0.f};
                }
                attn_qk(sacc, sb, *(const bf16x8*)(sQ + fr * 264 + j * 64 + fq * 8), *(const bf16x8*)(sQ + fr * 264 + j * 64 + 32 + fq * 8), fr, fq);
                if (j == 3) attn_softmax<16>(sacc, oacc, m, lsum, pb);
            } else if (j == 4) attn_pv<16, 0>(oacc, sb, pb, fr, fq);
            else if (j == 5) attn_pv<16, 4>(oacc, sb, pb, fr, fq);
            else if (j == 6) attn_pv<16, 8>(oacc, sb, pb, fr, fq);
            else attn_pv<16, 12>(oacc, sb, pb, fr, fq);
            if (j < 7 || kt == 0) chunk_store(rg, sbuf + ((j + 1) & 1) * 9216, (j >= 3 && j < 7), tid);
            __syncthreads();
            __builtin_amdgcn_sched_barrier(0);
        }
    }
    lsum += __shfl_xor(lsum, 16); lsum += __shfl_xor(lsum, 32);
    const float inv = 1.f / lsum;
#pragma unroll
    for (int i = 0; i < 16; ++i) {
        u32x2 o; o.x = pack2(oacc[i][0] * inv, oacc[i][1] * inv); o.y = pack2(oacc[i][2] * inv, oacc[i][3] * inv);
        *(u32x2*)(O + qrow * 1024 + h * 256 + i * 16 + fq * 4) = o;
    }
}

DI void moba_item(const Params& p, int item, char* lds) {
    const int tid = get_tid(), lane = tid & 63, w = tid >> 6, fr = lane & 15, fq = lane >> 4;
    const int qt = 31 - (item >> 7), bh = item & 127, h = bh & 15, b = bh >> 4;
    const u16* Q = (const u16*)(p.ws + O_H);
    const u16* Kd = (const u16*)(p.ws + O_H + 32 * MB) + ((size_t)b * SEQ) * 1024 + h * 64;
    const u16* Vt = (const u16*)(p.ws + O_H + 64 * MB) + ((size_t)(b * 16 + h) * 64) * 2048;
    const float* KM = (const float*)(p.ws + O_KM);
    u16* O = (u16*)(p.ws + O_YM);
    u16* sbuf = (u16*)lds;
    const int q0 = qt * 64, qblk = q0 >> 8, tq = q0 + w * 16 + fr;
    const size_t qrow = (size_t)b * SEQ + tq;
    bf16x8 bq[2];
#pragma unroll
    for (int i = 0; i < 2; ++i) bq[i] = *(const bf16x8*)(Q + qrow * 1024 + h * 64 + i * 32 + fq * 8);
    const int ktop = q0 >> 7, nchunk = 2 * (ktop + 1);
    u32x4 rg[4];
    chunk_load(rg, Kd + (size_t)ktop * 128 * 1024, 1024, false, tid);
    unsigned sel = 0;
    if (qblk > 0) {
        float aff[8];
#pragma unroll
        for (int j = 0; j < 8; ++j) aff[j] = 0.f;
        const u16* qp = Q + qrow * 1024 + h * 64;
        const float* km = KM + (size_t)bh * 8 * 64;
#pragma unroll
        for (int d8 = 0; d8 < 8; ++d8) {
            const u32x4 qv = *(const u32x4*)(qp + d8 * 8);
            float qf[8];
#pragma unroll
            for (int e = 0; e < 4; ++e) { qf[2 * e] = __uint_as_float(qv[e] << 16); qf[2 * e + 1] = __uint_as_float(qv[e] & 0xffff0000u); }
#pragma unroll
            for (int j = 0; j < 7; ++j)
                if (j < qblk) {
#pragma unroll
                    for (int e = 0; e < 8; ++e) aff[j] += qf[e] * km[j * 64 + d8 * 8 + e];
                }
        }
#pragma unroll
        for (int j = 0; j < 7; ++j) {
            int rank = 0;
#pragma unroll
            for (int j2 = 0; j2 < 7; ++j2) if (j2 < qblk && j2 != j && (aff[j2] > aff[j] || (aff[j2] == aff[j] && j2 < j))) ++rank;
            if (j < qblk && rank < 3) sel |= 1u << j;
        }
    }
    chunk_store(rg, sbuf, false, tid);
    __syncthreads();
    f32x4 oacc[4];
#pragma unroll
    for (int i = 0; i < 4; ++i) oacc[i] = (f32x4){0.f, 0.f, 0.f, 0.f};
    float m = -1e30f, lsum = 0.f;
    const float sl2 = exp2f(-0.5f * (float)(h + 1)) * 1.4426950408889634f;
    f32x4 sacc[8]; bf16x8 pb[4];
    for (int c = 0; c < nchunk; ++c) {
        const int kt = ktop - (c >> 1);
        if (c + 1 < nchunk) {
            if (c & 1) chunk_load(rg, Kd + (size_t)(kt - 1) * 128 * 1024, 1024, false, tid);
            else chunk_load(rg, Vt + kt * 128, 2048, true, tid);
        }
        if ((c & 1) == 0) {
#pragma unroll
            for (int i = 0; i < 8; ++i) sacc[i] = (f32x4){0.f, 0.f, 0.f, 0.f};
            attn_qk(sacc, sbuf, bq[0], bq[1], fr, fq);
            const int key0 = kt * 128, jb = key0 >> 8, dqi = tq - key0 - fq * 4;
            float base = -sl2 * (float)dqi;
            if (jb < qblk && !((sel >> jb) & 1u)) base = -1e30f;
            if (c == 0) {
#pragma unroll
                for (int mt = 0; mt < 8; ++mt)
#pragma unroll
                    for (int i = 0; i < 4; ++i) { const int e = mt * 16 + i; const float sv = fmaf(sl2, (float)e, sacc[mt][i] + base); sacc[mt][i] = (e <= dqi) ? sv : -1e30f; }
            } else {
#pragma unroll
                for (int mt = 0; mt < 8; ++mt)
#pragma unroll
                    for (int i = 0; i < 4; ++i) sacc[mt][i] = fmaf(sl2, (float)(mt * 16 + i), sacc[mt][i] + base);
            }
            attn_softmax<4>(sacc, oacc, m, lsum, pb);
        } else attn_pv<4, 0>(oacc, sbuf + 9216, pb, fr, fq);
        if (c + 1 < nchunk) chunk_store(rg, sbuf + ((c + 1) & 1) * 9216, ((c + 1) & 1) != 0, tid);
        __syncthreads();
    }
    lsum += __shfl_xor(lsum, 16); lsum += __shfl_xor(lsum, 32);
    const float inv = 1.f / lsum;
#pragma unroll
    for (int i = 0; i < 4; ++i) {
        u32x2 o; o.x = pack2(oacc[i][0] * inv, oacc[i][1] * inv); o.y = pack2(oacc[i][2] * inv, oacc[i][3] * inv);
        *(u32x2*)(O + qrow * 1024 + h * 64 + i * 16 + fq * 4) = o;
    }
}

DI void kmean_item(const Params& p, int item, char* lds) {
    const int tid = get_tid(), d = tid & 63, part = tid >> 6;
    const int j = item & 7, bh = item >> 3, h = bh & 15, b = bh >> 4;
    const u16* Kd = (const u16*)(p.ws + O_H + 32 * MB) + ((size_t)b * SEQ + j * 256 + part * 64) * 1024 + h * 64 + d;
    float* red = (float*)lds;
    float s = 0.f;
#pragma unroll 8
    for (int i = 0; i < 64; ++i) s += bf2f(Kd[(size_t)i * 1024]);
    __syncthreads();
    red[part * 64 + d] = s;
    __syncthreads();
    if (part == 0) ((float*)(p.ws + O_KM))[(size_t)item * 64 + d] = ((red[d] + red[64 + d]) + (red[128 + d] + red[192 + d])) * (1.f / 256.f);
}

DI void vtrans_item(const u16* src, int src_ld, u16* dst, int dst_ld, char* lds) {
    const int tid = get_tid();
    u16* sT = (u16*)lds;
    __syncthreads();
#pragma unroll
    for (int i = 0; i < 2; ++i) {
        const int c = tid + i * 256, r = c >> 3, cc = (c & 7) * 8;
        const u32x4 v = *(const u32x4*)(src + (size_t)r * src_ld + cc);
#pragma unroll
        for (int e = 0; e < 4; ++e) { sT[(cc + 2 * e) * 72 + r] = (u16)(v[e] & 0xffffu); sT[(cc + 2 * e + 1) * 72 + r] = (u16)(v[e] >> 16); }
    }
    __syncthreads();
#pragma unroll
    for (int i = 0; i < 2; ++i) {
        const int c = tid + i * 256, r = c >> 3, cc = (c & 7) * 8;
        *(u32x4*)(dst + (size_t)r * dst_ld + cc) = *(const u32x4*)(sT + r * 72 + cc);
    }
}
DI void vtrans_cross(const Params& p, int item, char* lds) {
    const int dt = item & 3, mt = (item >> 2) & 3, h = (item >> 4) & 3, b = (item >> 6) & 7, l = item >> 9;
    const u16* src = (const u16*)(p.ws + O_VRAW + l * 4 * MB) + ((size_t)b * 256 + mt * 64) * 1024 + h * 256 + dt * 64;
    u16* dst = (u16*)(p.ws + O_KVV + l * 4 * MB) + ((size_t)((b * 4 + h) * 256 + dt * 64)) * 256 + mt * 64;
    vtrans_item(src, 1024, dst, 256, lds);
}
DI void vtrans_moba(const Params& p, int item, char* lds) {
    const int tt = item & 31, h = (item >> 5) & 15, b = item >> 9;
    const u16* src = (const u16*)(p.ws + O_YM) + ((size_t)b * SEQ + tt * 64) * 1024 + h * 64;
    u16* dst = (u16*)(p.ws + O_H + 64 * MB) + ((size_t)((b * 16 + h) * 64)) * 2048 + tt * 64;
    vtrans_item(src, 1024, dst, 2048, lds);
}

__global__ void __launch_bounds__(512, 2) mega(Params p) {
    extern __shared__ __attribute__((aligned(16))) char lds[];
    cg::grid_group grid = cg::this_grid();
    char* ws = p.ws;
    volatile LAS unsigned* xst = (volatile LAS unsigned*)(lds + 2 * LDS_MAIN);
    if (threadIdx.x == 0) { xst[0] = 0u; xst[1] = 0u; xst[2] = 0u; xst[3] = 0u; }
    __syncthreads();
    const XcdBarrier xb = xcd_barrier_post((unsigned*)(ws + O_BAR), xst);
#ifdef TMASK
    unsigned long long t_prev = __builtin_amdgcn_s_memrealtime(), t_acc = 0;
#endif
    for (int pi = p.ph0; pi < p.ph1; ++pi) {
        int t_ = threadIdx.x; asm volatile("" : "+v"(t_));
        ws = p.ws; asm volatile("" : "+s"(ws));
        u16* XB = (u16*)(ws + O_XB); u16* Hb = (u16*)(ws + O_H); u16* YM = (u16*)(ws + O_YM);
        const int vb = t_ >> 8, vbid = blockIdx.x * 2 + vb, nvb = gridDim.x * 2;
        char* vlds = lds + vb * LDS_MAIN;
        const int ph = pi < 3 ? pi : (pi < 5 ? 21 + pi : pi - 2);
        const int l = (ph >= 12 && ph < 24) ? 1 : 0;
        const bool is_gemm = (ph == 1 || ph == 3 || ph == 5 || ph == 7 || ph == 9 || ph == 10 || ph == 12 || ph == 15 || ph == 17 || ph == 19 || ph == 21 || ph == 22);
        if (is_gemm) {
            for (int sub = 0; sub < (ph == 1 ? 2 : 1); ++sub) {
                const u16* A = XB; const u16* Bt = nullptr; int M = NT, N = 1024, K = 1024, et = 1;
                EpiSplit es; es.d0 = Hb; es.d1 = Hb; es.d2 = Hb; es.d3 = Hb; es.scale0 = 1.f;
                EpiZ ez; ez.res = p.out; ez.out = p.out;
                if (ph == 1 && sub == 0) { Bt = (const u16*)(ws + O_WT_EVIN); N = 3072; et = 0; }
                else if (ph == 1) { A = (const u16*)(ws + O_MEMB); Bt = (const u16*)(ws + O_WT_WKV); M = 2048; N = 4096;
                    es.d0 = (u16*)(ws + O_KVK); es.d1 = (u16*)(ws + O_VRAW); es.d2 = (u16*)(ws + O_KVK + 4 * MB); es.d3 = (u16*)(ws + O_VRAW + 4 * MB); }
                else if (ph == 5 || ph == 17) { Bt = (const u16*)(ws + O_WT_WQ + l * 2 * MB); es.scale0 = 0.0625f * 1.4426950408889634f; }
                else if (ph == 12) { Bt = (const u16*)(ws + O_WT_QKV); N = 3072; es.d1 = (u16*)(ws + O_H + 32 * MB); es.d2 = YM; es.d3 = YM; es.scale0 = 0.125f * 1.4426950408889634f; }
                else if (ph == 9 || ph == 21) { Bt = (const u16*)(ws + O_WT_FIN + l * 11 * MB); N = 2 * DFF; et = 3; }
                else {
                    et = 2;
                    const bool ffn = (ph == 10 || ph == 22);
                    A = ffn ? Hb : YM; K = ffn ? DFF : 1024;
                    if (ph == 3) ez.res = p.in[0];
                    const size_t wo = (ph == 3) ? O_WT_EVOUT : (ph == 15) ? O_WT_ODOUT : ffn ? (O_WT_FOUT + l * (11 * MB / 2)) : (O_WT_WO + l * 2 * MB);
                    Bt = (const u16*)(ws + wo);
                }
                if (et == 0) { EpiH0 e0; e0.H = Hb; e0.lbl = p.in[16]; run_gemm(lds, A, Bt, M, N, K, e0); }
                else if (et == 1) run_gemm(lds, A, Bt, M, N, K, es);
                else if (et == 2) run_gemm(lds, A, Bt, M, N, K, ez);
                else { EpiFFN e; e.Hd = Hb; run_gemm(lds, A, Bt, M, N, K, e); }
            }
        } else
        switch (ph) {
        case 0: phase_prep(p, vlds, vbid, nvb); break;
        case 2: { for (int it = vbid; it < 1024 + 512 + 1024; it += nvb) { if (it < 1024) hgrnA_item(p, it, vlds); else if (it < 1536) gmlp_item(p, it - 1024, vlds); else vtrans_cross(p, it - 1536, vlds); } } break;
        case 24: hgrn_scan(p); break;
        case 25: { for (int it = vbid; it < 1024; it += nvb) hgrnC_item(p, it, vlds); } break;
        case 4: case 8: case 11: case 16: case 20: case 23: {
            const int k = (ph == 4 || ph == 16) ? 0 : ((ph == 8 || ph == 20) ? 1 : 2);
            phase_ln(p.in[2] + (l * 3 + k) * 1024, p.in[3] + (l * 3 + k) * 1024, p.out, XB);
        } break;
        case 6: case 18: { for (int it = vbid; it < 1024; it += nvb) if (EN(6)) cross_item(p, l, it, vlds); } break;
        case 13: { for (int it = vbid; it < 1024 + 4096; it += nvb) { if (it < 1024) kmean_item(p, it, vlds); else vtrans_moba(p, it - 1024, vlds); } } break;
        case 14: { for (int it = vbid; it < 4096; it += nvb) if (EN(14)) moba_item(p, it, vlds); } break;
        default: break;
        }
        if (pi + 1 < p.ph1) { if (p.use_cg) grid.sync(); else xcd_barrier(xb); }
#ifdef TMASK
        { const unsigned long long now = __builtin_amdgcn_s_memrealtime(); if ((TMASK >> ph) & 1u) t_acc += now - t_prev; t_prev = now; }
        if (pi + 1 == p.ph1 && blockIdx.x == 0) { const unsigned long long t0 = __builtin_amdgcn_s_memrealtime(); while (__builtin_amdgcn_s_memrealtime() - t0 < t_acc) __builtin_amdgcn_s_sleep(8); }
#endif
    }
}

extern "C" void kernel_launch(void* const* d_in, const int* in_sizes, int n_in, void* d_out, int out_size, void* d_ws, size_t ws_size, hipStream_t stream) {
    static int grid = 0;
    if (grid == 0) {
        if (n_in != 19 || ws_size < WS_END) { fprintf(stderr, "kernel_launch: unexpected n_in %d / ws %zu (need %zu)\n", n_in, ws_size, (size_t)WS_END); grid = -1; return; }
        int dev = 0, cus = 0, per_cu = 0;
        (void)hipGetDevice(&dev);
        (void)hipDeviceGetAttribute(&cus, hipDeviceAttributeMultiprocessorCount, dev);
        if (hipFuncSetAttribute((const void*)mega, hipFuncAttributeMaxDynamicSharedMemorySize, LDS_BYTES) != hipSuccess) { fprintf(stderr, "hipFuncSetAttribute failed\n"); grid = -1; return; }
        if (hipOccupancyMaxActiveBlocksPerMultiprocessor(&per_cu, (const void*)mega, 512, LDS_BYTES) != hipSuccess || per_cu < 1) { fprintf(stderr, "occupancy query failed\n"); grid = -1; return; }
        grid = cus;
        grid -= grid % 8;
        fprintf(stderr, "kernel_launch: grid %d (cus %d per_cu %d)\n", grid, cus, per_cu);
    }
    if (grid < 0) return;
    Params p{};
    for (int i = 0; i < 19; ++i) p.in[i] = (const float*)d_in[i];
    p.out = (float*)d_out; p.ws = (char*)d_ws;
    p.ph0 = 0; p.ph1 = NPHASE; p.use_cg = 0;
    if (hipMemsetAsync((char*)d_ws + O_BAR, 0, XCD_BAR_WORDS * 4, stream) != hipSuccess) { fprintf(stderr, "memset failed\n"); return; }
    void* args[] = {&p};
    hipError_t e = hipLaunchCooperativeKernel((void*)mega, dim3(grid), dim3(512), args, LDS_BYTES, stream);
    if (e != hipSuccess) fprintf(stderr, "cooperative launch failed: %s (grid %d)\n", hipGetErrorString(e), grid);
}
```

```cpp
#include <hip/hip_runtime.h>
#include <hip/hip_cooperative_groups.h>
#include <cstdio>
#include <cstdint>
namespace cg = cooperative_groups;

#ifndef MULTI_LAUNCH
#define MULTI_LAUNCH 0
#endif

#ifndef PHMASK
#define PHMASK 0xFFFFFFFFu
#endif
#define EN(x) ((PHMASK >> (x)) & 1u)
#define DI __device__ __forceinline__
typedef unsigned short u16;
typedef short bf16x8 __attribute__((ext_vector_type(8)));
typedef float f32x4 __attribute__((ext_vector_type(4)));
typedef unsigned u32x4 __attribute__((ext_vector_type(4)));
typedef unsigned u32x2 __attribute__((ext_vector_type(2)));

constexpr int NT = 16384, DM = 1024, SEQ = 2048;
constexpr int DFF = 2816;
constexpr float ALPHA = 1.41421356237309515f;
constexpr float LN_EPS = 1e-5f;
constexpr int LDS_MAIN = 73728;
constexpr int LDS_BYTES = 2 * LDS_MAIN + 32;
constexpr int NPHASE = 26;

constexpr size_t MB = 1u << 20;
constexpr size_t O_WT_EVIN = 0;
constexpr size_t O_WT_EVOUT = O_WT_EVIN + 6 * MB;
constexpr size_t O_WT_WQ = O_WT_EVOUT + 2 * MB;
constexpr size_t O_WT_WKV = O_WT_WQ + 4 * MB;
constexpr size_t O_WT_WO = O_WT_WKV + 8 * MB;
constexpr size_t O_WT_FIN = O_WT_WO + 4 * MB;
constexpr size_t O_WT_FOUT = O_WT_FIN + 22 * MB;
constexpr size_t O_WT_QKV = O_WT_FOUT + 11 * MB;
constexpr size_t O_WT_ODOUT = O_WT_QKV + 6 * MB;
constexpr size_t O_XB = O_WT_ODOUT + 2 * MB;
constexpr size_t O_H = O_XB + 32 * MB;
constexpr size_t O_YM = O_H + 96 * MB;
constexpr size_t O_MEMB = O_YM + 32 * MB;
constexpr size_t O_KVK = O_MEMB + 4 * MB;
constexpr size_t O_KVV = O_KVK + 8 * MB;
constexpr size_t O_KM = O_KVV + 8 * MB;
constexpr size_t O_BAR = O_KM + MB;
constexpr size_t O_VRAW = O_BAR + MB;
constexpr size_t WS_END = O_VRAW + 8 * MB;

struct Params { const float* in[19]; float* out; char* ws; int ph0, ph1; int use_cg, pad; };

DI int get_tid8() { int t = threadIdx.x; asm volatile("" : "+v"(t)); return t; }
DI int get_tid() { int t = threadIdx.x & 255; asm volatile("" : "+v"(t)); return t; }
DI u16 f2bf(float x) { unsigned u = __float_as_uint(x); u += 0x7fffu + ((u >> 16) & 1u); return (u16)(u >> 16); }
DI float bf2f(u16 h) { return __uint_as_float(((unsigned)h) << 16); }
DI unsigned pack2(float a, float b) { return (unsigned)f2bf(a) | ((unsigned)f2bf(b) << 16); }
DI f32x4 mfma16(bf16x8 a, bf16x8 b, f32x4 c) { return __builtin_amdgcn_mfma_f32_16x16x32_bf16(a, b, c, 0, 0, 0); }
DI bf16x8 mk8(u32x2 lo, u32x2 hi) { u32x4 t; t.x = lo.x; t.y = lo.y; t.z = hi.x; t.w = hi.y; return __builtin_bit_cast(bf16x8, t); }
DI bf16x8 pack8(f32x4 a, f32x4 b) { u32x4 t; t.x = pack2(a[0], a[1]); t.y = pack2(a[2], a[3]); t.z = pack2(b[0], b[1]); t.w = pack2(b[2], b[3]); return __builtin_bit_cast(bf16x8, t); }
DI float gelu_tanh(float x) { float y = 0.7978845608028654f * (x + 0.044715f * x * x * x); float t = 1.f - 2.f / (1.f + __expf(2.f * y)); return 0.5f * x * (1.f + t); }
DI float sigmoidf(float x) { return 1.f / (1.f + __expf(-x)); }
DI float siluf(float x) { return x / (1.f + __expf(-x)); }


#define XB_TMO      128
#define XB_XCNT(j)  (256  + 64 * (j))
#define XB_XSUB(j)  (1280 + 64 * (j))
#define XB_XGEN(j)  (2304 + 64 * (j))
#define XB_TOP      3328
#define XB_TOPGEN   3392
#define XCD_BAR_WORDS 3456
#define XB_SPIN_CAP (1u << 18)
#define LAS __attribute__((address_space(3)))
DI unsigned xb_ld(unsigned* p) { return __hip_atomic_load(p, __ATOMIC_RELAXED, __HIP_MEMORY_SCOPE_AGENT); }
DI unsigned xb_add(unsigned* p, unsigned v) { return __hip_atomic_fetch_add(p, v, __ATOMIC_RELAXED, __HIP_MEMORY_SCOPE_AGENT); }
DI unsigned xb_xcc_id() { return (unsigned)__builtin_amdgcn_s_getreg((3 << 11) | 20) & 0xFu; }
#define XB_SPIN(cond, bar) do { unsigned _sp = 0; while (cond) { __builtin_amdgcn_s_sleep(1); \
    if ((++_sp & 255u) == 0u) { if (xb_ld(&(bar)[XB_TMO])) break; if (_sp > XB_SPIN_CAP) { atomicAdd(&(bar)[XB_TMO], 1u); break; } } } } while (0)
struct XcdBarrier { unsigned* bar; unsigned x; volatile LAS unsigned* st; };
DI XcdBarrier xcd_barrier_post(unsigned* bar, volatile LAS unsigned* st) {
    XcdBarrier b; b.bar = bar; b.x = xb_xcc_id(); b.st = st;
    if (threadIdx.x == 0) (void)xb_add(&bar[XB_XCNT(b.x)], 1u);
    return b;
}
DI void xcd_barrier_complete(unsigned* bar, unsigned x, unsigned& nloc, unsigned& nx) {
    const unsigned G = gridDim.x * gridDim.y * gridDim.z;
    unsigned sum, cnt, mine, sp = 0u;
    for (;;) {
        sum = 0u; cnt = 0u; mine = 0u;
#pragma unroll
        for (unsigned j = 0; j < 16; ++j) { const unsigned c = xb_ld(&bar[XB_XCNT(j)]); sum += c; cnt += (c > 0u) ? 1u : 0u; mine = (j == x) ? c : mine; }
        if (sum == G) break;
        __builtin_amdgcn_s_sleep(1);
        if ((++sp & 255u) == 0u) { if (xb_ld(&bar[XB_TMO])) break; if (sp > XB_SPIN_CAP) { atomicAdd(&bar[XB_TMO], 1u); break; } }
    }
    nloc = mine > 0u ? mine : 1u; nx = cnt > 0u ? cnt : 1u;
}
DI void xcd_barrier(const XcdBarrier& b) {
    asm volatile("s_waitcnt vmcnt(0)" ::: "memory");
    __syncthreads();
    if (threadIdx.x == 0) {
        unsigned* bar = b.bar;
        __builtin_amdgcn_s_waitcnt(0);
        unsigned nloc = b.st[0], nx = b.st[1];
        if (nloc == 0u) { xcd_barrier_complete(bar, b.x, nloc, nx); b.st[0] = nloc; b.st[1] = nx; }
        const unsigned old = xb_add(&bar[XB_XSUB(b.x)], 1u);
        const unsigned gen = old / nloc;
        if (old + 1u == (gen + 1u) * nloc) {
            __builtin_amdgcn_fence(__ATOMIC_RELEASE, "agent");
            asm volatile("s_waitcnt vmcnt(0)" ::: "memory");
            const unsigned og = xb_add(&bar[XB_TOP], 1u);
            const unsigned tg = og / nx;
            if (og + 1u == (tg + 1u) * nx) xb_add(&bar[XB_TOPGEN], 1u);
            else XB_SPIN(xb_ld(&bar[XB_TOPGEN]) == tg, bar);
            __builtin_amdgcn_fence(__ATOMIC_ACQUIRE, "agent");
            xb_add(&bar[XB_XGEN(b.x)], 1u);
            asm volatile("s_waitcnt vmcnt(0)" ::: "memory");
        } else {
            XB_SPIN(xb_ld(&bar[XB_XGEN(b.x)]) == gen, bar);
            __builtin_amdgcn_fence(__ATOMIC_ACQUIRE, "agent");
            asm volatile("s_waitcnt vmcnt(0)" ::: "memory");
        }
    }
    __syncthreads();
}

namespace pg8 {
#define PG8_LAS __attribute__((address_space(3)))
typedef unsigned short bf16_t;
typedef short bf16x8 __attribute__((ext_vector_type(8)));
typedef float f32x4 __attribute__((ext_vector_type(4)));
typedef unsigned u32x4 __attribute__((ext_vector_type(4)));
constexpr int BM = 256, BK = 64, HALF = 128, HTB = HALF * BK * 2  , STAGE_BYTES = 8 * HTB, NXCD = 8, WGM = 8;

__host__ __device__ __forceinline__ int lds_byte(int r, int c) { const int st = (r >> 4) * 2 + (c >> 5), rr = r & 15, cc = c & 31, ob = rr * 64 + cc * 2; return st * 1024 + (ob ^ (((ob >> 9) & 1) << 5)); }
__host__ __device__ __forceinline__ void stage_rc(int b, int& R, int& C) { const int st = b / 1024, sb = b % 1024, swz = sb ^ (((sb >> 9) & 1) << 5); R = (st >> 1) * 16 + swz / 64; C = (st & 1) * 32 + (swz % 64) / 2; }
__host__ __device__ __forceinline__ int perm32(int rho) { const int n = rho >> 4, i = rho & 15; return 8 * (i >> 2) + 4 * n + (i & 3); }

struct Unit { int pm, pn; };
struct Gemm { const bf16_t* A; const bf16_t* Bt; int M, N, K; };

struct StaticOrder {
    int nM, nN, nwg, G, c;
    __host__ __device__ void init(int M, int N, int G_, int c_) { nM = M / BM; nN = N / BM; nwg = nM * nN; G = G_; c = c_; }
    __host__ __device__ bool next(int i, Unit& u) const {
        const long L = (long)i * G + c; if (L >= nwg) return false;
        int wgid = (int)L; { const int q = nwg / NXCD, r = nwg % NXCD, xcd = wgid % NXCD, off = wgid / NXCD; wgid = (xcd < r ? xcd * (q + 1) : r * (q + 1) + (xcd - r) * q) + off; }
        const int nig = WGM * nN, gid = wgid / nig, fm = gid * WGM, gsz = (nM - fm) < WGM ? (nM - fm) : WGM;
        u.pm = fm + ((wgid % nig) % gsz); u.pn = (wgid % nig) / gsz; return true;
    }
    __device__ __forceinline__ void a_ready(const Unit&) const {}
    __device__ __forceinline__ void done(const Unit&) const {}
};

template <class Epi, class Sched, bool ALIGN_EPI = false, bool SP2 = false>
__device__ __forceinline__ void gemm_phase(PG8_LAS unsigned char* lds, const Gemm g, const Sched& S, const Epi& E) {
    int tid_ = threadIdx.x; asm volatile("" : "+v"(tid_)); const int tid = tid_, wid = __builtin_amdgcn_readfirstlane(tid >> 6), lane = tid & 63, wr = wid >> 2, wc = wid & 3, fr = lane & 15, fq = lane >> 4;
    const int K = g.K, nt = K / BK;
    unsigned voffA[2], voffB[2];
#pragma unroll
    for (int i = 0; i < 2; ++i) { int R, C; stage_rc(tid * 16 + i * 8192, R, C); const int Rb = Epi::PERM ? ((R & ~31) + perm32(R & 31)) : R;
        voffA[i] = (unsigned)(R * K + C) * 2u; voffB[i] = (unsigned)(Rb * K + C) * 2u; }
    const size_t kstep = (size_t)(BK * 2);
    const size_t hstep = (size_t)HALF * K * 2;
    const size_t tstep = 2 * hstep;
    const unsigned ldsw = (unsigned)wid * 1024u;
    const int aoff = lds_byte(wr * 64 + fr, fq * 8), boff = lds_byte(wc * 32 + fr, fq * 8);
#define PG8_SA(b, h) (((b) * 2 + (h)) * HTB)
#define PG8_SB(b, h) ((4 + (b) * 2 + (h)) * HTB)
#define PG8_STAGE(bufoff, gbase, voff) do { _Pragma("unroll") for (int _i = 0; _i < 2; ++_i) \
        __builtin_amdgcn_global_load_lds((const unsigned*)((const char*)(gbase) + (voff)[_i]), (PG8_LAS unsigned*)(lds + (bufoff) + ldsw + _i * 8192), 16, 0, 0); } while (0)
#define PG8_LDA(dst, b, h) do { _Pragma("unroll") for (int m = 0; m < 4; ++m) _Pragma("unroll") for (int k = 0; k < 2; ++k) dst[m][k] = *(const PG8_LAS bf16x8*)(lds + PG8_SA(b, h) + aoff + m * 2048 + k * 1024); } while (0)
#define PG8_LDB(dst, b, h) do { _Pragma("unroll") for (int n = 0; n < 2; ++n) _Pragma("unroll") for (int k = 0; k < 2; ++k) dst[n][k] = *(const PG8_LAS bf16x8*)(lds + PG8_SB(b, h) + boff + n * 2048 + k * 1024); } while (0)
#define PG8_MMA(ai, bj, At, Bt) do { __builtin_amdgcn_s_setprio(1); _Pragma("unroll") for (int m = 0; m < 4; ++m) _Pragma("unroll") for (int n = 0; n < 2; ++n) _Pragma("unroll") for (int k = 0; k < 2; ++k) \
        acc[ai][bj][m][n] = __builtin_amdgcn_mfma_f32_16x16x32_bf16(Bt[n][k], At[m][k], acc[ai][bj][m][n], 0, 0, 0); __builtin_amdgcn_s_setprio(0); } while (0)
#define PG8_WAIT_V(n) asm volatile("s_waitcnt vmcnt(" #n ")" ::: "memory")
#define PG8_WAIT_L(n) asm volatile("s_waitcnt lgkmcnt(" #n ")" ::: "memory")
#define PG8_BAR __builtin_amdgcn_s_barrier()
#define PG8_SCHED __builtin_amdgcn_sched_barrier(0)
    Unit cur, nxt; int ui = 0;
    if (!S.next(0, cur)) return;
    f32x4 acc[2][2][4][2];
#pragma unroll
    for (int a = 0; a < 2; ++a)
#pragma unroll
        for (int b = 0; b < 2; ++b)
#pragma unroll
            for (int m = 0; m < 4; ++m)
#pragma unroll
                for (int n = 0; n < 2; ++n) acc[a][b][m][n] = (f32x4){0.f, 0.f, 0.f, 0.f};
    bf16x8 At[4][2], B0[2][2], B1[2][2];
    const char* cA = (const char*)g.A + (size_t)cur.pm * tstep; const char* cB = (const char*)g.Bt + (size_t)cur.pn * tstep;
    S.a_ready(cur);
    if constexpr (SP2) {
        PG8_STAGE(PG8_SB(0, 0), cB, voffB); PG8_STAGE(PG8_SB(0, 1), cB + hstep, voffB); PG8_STAGE(PG8_SA(0, 0), cA, voffA); PG8_STAGE(PG8_SA(0, 1), cA + hstep, voffA);
        if (wr == 1) PG8_BAR;
        PG8_WAIT_V(2); PG8_BAR;
        PG8_STAGE(PG8_SB(1, 0), cB + kstep, voffB); PG8_STAGE(PG8_SA(1, 0), cA + kstep, voffA); PG8_STAGE(PG8_SB(1, 1), cB + hstep + kstep, voffB);
        PG8_WAIT_V(6); PG8_BAR;
    } else {
        PG8_STAGE(PG8_SB(0, 0), cB, voffB); PG8_STAGE(PG8_SA(0, 0), cA, voffA); PG8_STAGE(PG8_SB(0, 1), cB + hstep, voffB); PG8_STAGE(PG8_SA(0, 1), cA + hstep, voffA);
        if (wr == 1) PG8_BAR;
        PG8_WAIT_V(4); PG8_BAR;
        PG8_STAGE(PG8_SB(1, 0), cB + kstep, voffB); PG8_STAGE(PG8_SA(1, 0), cA + kstep, voffA); PG8_STAGE(PG8_SB(1, 1), cB + hstep + kstep, voffB);
        PG8_WAIT_V(6); PG8_BAR;
    }
    for (;;) {
        const bool has_next = S.next(ui + 1, nxt);
        const char* nA = has_next ? (const char*)g.A + (size_t)nxt.pm * tstep : cA; const char* nB = has_next ? (const char*)g.Bt + (size_t)nxt.pn * tstep : cB;
        for (int t = 0; t < nt; t += 2) {
            const bool last = (t == nt - 2);
            const char* a1 = cA + (size_t)(t + 1) * kstep;
            const char* a2 = last ? nA : cA + (size_t)(t + 2) * kstep; const char* b2 = last ? nB : cB + (size_t)(t + 2) * kstep;
            const char* a3 = a2 + kstep; const char* b3 = b2 + kstep;
            if (last && has_next) S.a_ready(nxt);
            if constexpr (SP2) {
            PG8_LDB(B0, 0, 0); PG8_LDB(B1, 0, 1); PG8_SCHED; PG8_LDA(At, 0, 0); PG8_STAGE(PG8_SA(1, 1), a1 + hstep, voffA);
            PG8_WAIT_V(8); PG8_WAIT_L(0); PG8_BAR; PG8_MMA(0, 0, At, B0); PG8_MMA(0, 1, At, B1); PG8_BAR; PG8_SCHED;
            PG8_LDA(At, 0, 1); PG8_STAGE(PG8_SB(0, 0), b2, voffB); PG8_STAGE(PG8_SB(0, 1), b2 + hstep, voffB); PG8_STAGE(PG8_SA(0, 0), a2, voffA);
            PG8_WAIT_V(8); PG8_WAIT_L(0); PG8_BAR; PG8_MMA(1, 0, At, B0); PG8_MMA(1, 1, At, B1); PG8_BAR; PG8_SCHED;
            PG8_LDB(B0, 1, 0); PG8_LDB(B1, 1, 1); PG8_SCHED; PG8_LDA(At, 1, 0); PG8_STAGE(PG8_SA(0, 1), a2 + hstep, voffA);
            PG8_WAIT_V(8); PG8_WAIT_L(0); PG8_BAR; PG8_MMA(0, 0, At, B0); PG8_MMA(0, 1, At, B1); PG8_BAR; PG8_SCHED;
            PG8_LDA(At, 1, 1); PG8_STAGE(PG8_SB(1, 0), b3, voffB); PG8_STAGE(PG8_SB(1, 1), b3 + hstep, voffB); PG8_STAGE(PG8_SA(1, 0), a3, voffA);
            PG8_WAIT_V(8); PG8_WAIT_L(0); PG8_BAR; PG8_MMA(1, 0, At, B0); PG8_MMA(1, 1, At, B1); PG8_BAR; PG8_SCHED;
            } else {
            PG8_LDB(B0, 0, 0); PG8_SCHED; PG8_LDA(At, 0, 0); PG8_STAGE(PG8_SA(1, 1), a1 + hstep, voffA);
            PG8_WAIT_L(8); PG8_BAR; PG8_WAIT_L(0); PG8_MMA(0, 0, At, B0); PG8_BAR; PG8_SCHED;
            PG8_LDB(B1, 0, 1); PG8_STAGE(PG8_SB(0, 0), b2, voffB);
            PG8_BAR; PG8_WAIT_L(0); PG8_MMA(0, 1, At, B1); PG8_BAR;
            PG8_LDA(At, 0, 1); PG8_STAGE(PG8_SA(0, 0), a2, voffA);
            PG8_BAR; PG8_WAIT_L(0); PG8_MMA(1, 0, At, B0); PG8_BAR; PG8_SCHED;
            PG8_STAGE(PG8_SB(0, 1), b2 + hstep, voffB);
            PG8_WAIT_V(6); PG8_BAR; PG8_MMA(1, 1, At, B1); PG8_BAR;
            PG8_LDB(B0, 1, 0); PG8_SCHED; PG8_LDA(At, 1, 0); PG8_STAGE(PG8_SA(0, 1), a2 + hstep, voffA);
            PG8_WAIT_L(8); PG8_BAR; PG8_WAIT_L(0); PG8_MMA(0, 0, At, B0); PG8_BAR; PG8_SCHED;
            PG8_LDB(B1, 1, 1); PG8_STAGE(PG8_SB(1, 0), b3, voffB);
            PG8_BAR; PG8_WAIT_L(0); PG8_MMA(0, 1, At, B1); PG8_BAR;
            PG8_LDA(At, 1, 1); PG8_STAGE(PG8_SA(1, 0), a3, voffA);
            PG8_BAR; PG8_WAIT_L(0); PG8_MMA(1, 0, At, B0); PG8_BAR; PG8_SCHED;
            PG8_STAGE(PG8_SB(1, 1), b3 + hstep, voffB);
            PG8_WAIT_V(6); PG8_BAR; PG8_MMA(1, 1, At, B1); PG8_BAR;
            }
        }
        if constexpr (ALIGN_EPI) { if (wr == 0) PG8_BAR; }
        if constexpr (!Epi::AFTER_DRAIN) { E(acc, cur, wr, wc, fr, fq); S.done(cur); }
        if (!has_next) break;
#pragma unroll
        for (int a = 0; a < 2; ++a)
#pragma unroll
            for (int b = 0; b < 2; ++b)
#pragma unroll
                for (int m = 0; m < 4; ++m)
#pragma unroll
                    for (int n = 0; n < 2; ++n) acc[a][b][m][n] = (f32x4){0.f, 0.f, 0.f, 0.f};
        cur = nxt; cA = nA; cB = nB; ++ui;
        if constexpr (ALIGN_EPI) { if (wr == 1) PG8_BAR; }
    }
    PG8_WAIT_V(0);
    if constexpr (!ALIGN_EPI) { if (wr == 0) PG8_BAR; }
    PG8_BAR;
    if constexpr (Epi::AFTER_DRAIN) { E.fused(acc, cur, wr, wc, fr, fq, lds, wid, lane); S.done(cur); }
#undef PG8_SA
#undef PG8_SB
#undef PG8_STAGE
#undef PG8_LDA
#undef PG8_LDB
#undef PG8_MMA
#undef PG8_WAIT_V
#undef PG8_WAIT_L
#undef PG8_BAR
#undef PG8_SCHED
}
}

typedef pg8::Unit Unit;
#define EPI8 _Pragma("unroll") for (int ai = 0; ai < 2; ++ai) _Pragma("unroll") for (int m = 0; m < 4; ++m) _Pragma("unroll") for (int bj = 0; bj < 2; ++bj)
#define EROW (u.pm * 256 + ai * 128 + wr * 64 + m * 16 + fr)
#define ECOL (u.pn * 256 + bj * 128 + wc * 32 + 8 * fq)
DI u32x4 pk8(f32x4 a, f32x4 b) { u32x4 o; o.x = pack2(a[0], a[1]); o.y = pack2(a[2], a[3]); o.z = pack2(b[0], b[1]); o.w = pack2(b[2], b[3]); return o; }

#define EOFF(ld) ((unsigned)EROW * (unsigned)(ld) + (unsigned)ECOL)
#define ESB __builtin_amdgcn_sched_barrier(0)
struct EpiH0 {
    static constexpr bool PERM = true, AFTER_DRAIN = false;
    u16* H; const float* lbl;
    DI void operator()(const f32x4 (&acc)[2][2][4][2], const Unit& u, int wr, int wc, int fr, int fq) const {
        const int region = (u.pn * 256) >> 9;
        EPI8 {
            const unsigned col = ECOL;
            f32x4 v0 = acc[ai][bj][m][0], v1 = acc[ai][bj][m][1];
            if (region <= 1) { _Pragma("unroll") for (int r = 0; r < 4; ++r) { v0[r] = gelu_tanh(v0[r]); v1[r] = gelu_tanh(v1[r]); } }
            else if (region == 3) {
                const f32x4 a0 = *(const f32x4*)(lbl + (col - 1536u)), a1 = *(const f32x4*)(lbl + (col - 1536u + 4u)), b0 = *(const f32x4*)(lbl + (col - 1024u)), b1 = *(const f32x4*)(lbl + (col - 1024u + 4u));
                _Pragma("unroll") for (int r = 0; r < 4; ++r) {
                    const float lb0 = 1.f / (1.f + __expf(b0[r] - a0[r])), lb1 = 1.f / (1.f + __expf(b1[r] - a1[r]));
                    v0[r] = __logf(lb0 + (1.f - lb0) * sigmoidf(v0[r])); v1[r] = __logf(lb1 + (1.f - lb1) * sigmoidf(v1[r]));
                }
            }
            else if (region >= 4) { _Pragma("unroll") for (int r = 0; r < 4; ++r) { v0[r] = siluf(v0[r]); v1[r] = siluf(v1[r]); } }
            *(u32x4*)(H + EOFF(3072)) = pk8(v0, v1);
            ESB;
        }
    }
};
struct EpiSplit {
    static constexpr bool PERM = true, AFTER_DRAIN = false;
    u16* d0; u16* d1; u16* d2; u16* d3; float scale0;
    DI void operator()(const f32x4 (&acc)[2][2][4][2], const Unit& u, int wr, int wc, int fr, int fq) const {
        const int reg = (u.pn * 256) >> 10;
        u16* D = reg == 0 ? d0 : (reg == 1 ? d1 : (reg == 2 ? d2 : d3));
        const float sc = reg == 0 ? scale0 : 1.f;
        EPI8 { *(u32x4*)(D + ((unsigned)EROW * 1024u + ((unsigned)ECOL & 1023u))) = pk8(acc[ai][bj][m][0] * sc, acc[ai][bj][m][1] * sc); ESB; }
    }
};
struct EpiZ {
    static constexpr bool PERM = true, AFTER_DRAIN = false;
    const float* res; float* out;
    DI void operator()(const f32x4 (&acc)[2][2][4][2], const Unit& u, int wr, int wc, int fr, int fq) const {
        EPI8 { const unsigned o = EOFF(1024);
            const f32x4 r0 = *(const f32x4*)(res + o), r1 = *(const f32x4*)(res + o + 4u);
            *(f32x4*)(out + o) = r0 * ALPHA + acc[ai][bj][m][0];
            *(f32x4*)(out + o + 4u) = r1 * ALPHA + acc[ai][bj][m][1]; ESB; }
    }
};
struct EpiFFN {
    static constexpr bool PERM = true, AFTER_DRAIN = false;
    u16* Hd;
    DI void operator()(const f32x4 (&acc)[2][2][4][2], const Unit& u, int wr, int wc, int fr, int fq) const {
#pragma unroll
        for (int ai = 0; ai < 2; ++ai)
#pragma unroll
            for (int m = 0; m < 4; ++m) {
                f32x4 v0, v1;
#pragma unroll
                for (int r = 0; r < 4; ++r) { v0[r] = siluf(acc[ai][0][m][0][r]) * acc[ai][1][m][0][r]; v1[r] = siluf(acc[ai][0][m][1][r]) * acc[ai][1][m][1][r]; }
                *(u32x4*)(Hd + ((unsigned)EROW * (unsigned)DFF + (unsigned)(u.pn * 128 + wc * 32 + 8 * fq))) = pk8(v0, v1);
                ESB;
            }
    }
};
template <class Epi>
DI void run_gemm(char* lds, const u16* A, const u16* Bt, int M, int N, int K, const Epi& epi) {
    pg8::Gemm g; g.A = A; g.Bt = Bt; g.M = M; g.N = N; g.K = K;
    pg8::StaticOrder so; so.init(M, N, gridDim.x, blockIdx.x);
    pg8::gemm_phase<Epi, pg8::StaticOrder, true, true>((PG8_LAS unsigned char*)lds, g, so, epi);
}

extern __shared__ __attribute__((aligned(16))) char g_lds[];
DI void vsync() {
    asm volatile("s_waitcnt vmcnt(0) lgkmcnt(0)" ::: "memory");
    LAS unsigned* cnt = (LAS unsigned*)(g_lds + 2 * LDS_MAIN + 16) + (threadIdx.x >> 8);
    unsigned tgt = 0;
    if ((threadIdx.x & 63) == 0) { const unsigned old = __hip_atomic_fetch_add(cnt, 1u, __ATOMIC_RELAXED, __HIP_MEMORY_SCOPE_WORKGROUP); tgt = (old & ~3u) + 4u; }
    tgt = __builtin_amdgcn_readfirstlane(tgt);
    while (__hip_atomic_load(cnt, __ATOMIC_RELAXED, __HIP_MEMORY_SCOPE_WORKGROUP) < tgt) __builtin_amdgcn_s_sleep(1);
    asm volatile("" ::: "memory");
}

struct TrItem { const float* W; u16* WT; int K, N, perm, k0, n0; };
DI TrItem tr_decode(const Params& p, int r) {
    char* ws = p.ws;
    constexpr int T1 = 16 * 48, TS = 16 * 16, TKV = 16 * 32, TFI = 16 * 88, TFO = 44 * 16;
    TrItem t; t.perm = 0; t.K = 1024; t.N = 1024;
    if (r < T1) { t.W = p.in[9]; t.N = 3072; t.WT = (u16*)(ws + O_WT_EVIN); }
    else if ((r -= T1) < TS) { t.W = p.in[10]; t.WT = (u16*)(ws + O_WT_EVOUT); }
    else if ((r -= TS) < 2 * TS) { const int l = r / TS; r %= TS; t.W = p.in[4] + (size_t)l * 1024 * 1024; t.WT = (u16*)(ws + O_WT_WQ + l * 2 * MB); }
    else if ((r -= 2 * TS) < 2 * TKV) { const int l = r / TKV; r %= TKV; t.W = p.in[5] + (size_t)l * 1024 * 2048; t.N = 2048; t.WT = (u16*)(ws + O_WT_WKV + l * 4 * MB); }
    else if ((r -= 2 * TKV) < 2 * TS) { const int l = r / TS; r %= TS; t.W = p.in[6] + (size_t)l * 1024 * 1024; t.WT = (u16*)(ws + O_WT_WO + l * 2 * MB); }
    else if ((r -= 2 * TS) < 2 * TFI) { const int l = r / TFI; r %= TFI; t.W = p.in[7] + (size_t)l * 1024 * 5632; t.N = 5632; t.perm = 1; t.WT = (u16*)(ws + O_WT_FIN + l * 11 * MB); }
    else if ((r -= 2 * TFI) < 2 * TFO) { const int l = r / TFO; r %= TFO; t.W = p.in[8] + (size_t)l * 2816 * 1024; t.K = 2816; t.WT = (u16*)(ws + O_WT_FOUT + l * (11 * MB / 2)); }
    else if ((r -= 2 * TFO) < T1) { t.W = p.in[17]; t.N = 3072; t.WT = (u16*)(ws + O_WT_QKV); }
    else { r -= T1; t.W = p.in[18]; t.WT = (u16*)(ws + O_WT_ODOUT); }
    const int ntn = t.N >> 6; t.k0 = (r / ntn) * 64; t.n0 = (r % ntn) * 64;
    return t;
}
DI void tr_load(const TrItem& t, f32x4 (&r)[4], int tid) {
#pragma unroll
    for (int i = 0; i < 4; ++i) r[i] = *(const f32x4*)(t.W + (size_t)(t.k0 + (tid >> 4) + 16 * i) * t.N + t.n0 + (tid & 15) * 4);
}

DI void phase_prep(const Params& p, char* lds, int vbid, int nvb) {
    float* scr = (float*)lds;
    const int tid = get_tid();
    constexpr int NTR = 16 * 48 * 2 + 16 * 16 * 6 + 16 * 32 * 2 + 16 * 88 * 2 + 44 * 16 * 2;
    constexpr int NXC = NT * DM / 2048, NMC = 2048 * DM / 2048;
    {
        int it = vbid; bool have = it < NTR;
        TrItem t; f32x4 r[4];
        if (have) { t = tr_decode(p, it); tr_load(t, r, tid); }
        while (have) {
            const int nxt = it + nvb; const bool hn = nxt < NTR;
            vsync();
#pragma unroll
            for (int i = 0; i < 4; ++i) { float* d = scr + ((tid >> 4) + 16 * i) * 65 + (tid & 15) * 4; d[0] = r[i][0]; d[1] = r[i][1]; d[2] = r[i][2]; d[3] = r[i][3]; }
            const TrItem cur = t;
            if (hn) { t = tr_decode(p, nxt); tr_load(t, r, tid); }
            vsync();
            const int n = tid >> 2, c = tid & 3;
            const float* s = scr + (c * 16) * 65 + n;
            u32x4 o0, o1;
            o0.x = pack2(s[0 * 65], s[1 * 65]); o0.y = pack2(s[2 * 65], s[3 * 65]); o0.z = pack2(s[4 * 65], s[5 * 65]); o0.w = pack2(s[6 * 65], s[7 * 65]);
            o1.x = pack2(s[8 * 65], s[9 * 65]); o1.y = pack2(s[10 * 65], s[11 * 65]); o1.z = pack2(s[12 * 65], s[13 * 65]); o1.w = pack2(s[14 * 65], s[15 * 65]);
            const int nsrc = cur.n0 + n; int drow = nsrc;
            if (cur.perm) { if (nsrc < DFF) drow = (nsrc >> 7) * 256 + (nsrc & 127); else { const int n2 = nsrc - DFF; drow = (n2 >> 7) * 256 + 128 + (n2 & 127); } }
            u32x4* dst = (u32x4*)(cur.WT + (size_t)drow * cur.K + cur.k0 + c * 16);
            dst[0] = o0; dst[1] = o1;
            it = nxt; have = hn;
        }
    }
    for (int it = vbid * 4; it < NXC + NMC; it += nvb * 4) {
        f32x4 a[4], b[4];
#pragma unroll
        for (int u = 0; u < 4; ++u) {
            const int r = it + u; const float* src = r < NXC ? p.in[0] + (size_t)r * 2048 : p.in[1] + (size_t)(r - NXC) * 2048;
            a[u] = *(const f32x4*)(src + tid * 8); b[u] = *(const f32x4*)(src + tid * 8 + 4);
        }
#pragma unroll
        for (int u = 0; u < 4; ++u) {
            const int r = it + u; u16* dst = r < NXC ? (u16*)(p.ws + O_XB) + (size_t)r * 2048 : (u16*)(p.ws + O_MEMB) + (size_t)(r - NXC) * 2048;
            u32x4 o; o.x = pack2(a[u][0], a[u][1]); o.y = pack2(a[u][2], a[u][3]); o.z = pack2(b[u][0], b[u][1]); o.w = pack2(b[u][2], b[u][3]);
            *(u32x4*)(dst + tid * 8) = o;
        }
    }
}

DI void phase_ln(const float* __restrict__ g, const float* __restrict__ bta, float* xio, u16* xb) {
    const int tid8 = get_tid8(), lane = tid8 & 63, gw = blockIdx.x * 8 + (tid8 >> 6), nw = gridDim.x * 8;
    for (int row = gw; row < NT; row += nw) {
        f32x4* xr = (f32x4*)(xio + (size_t)row * 1024);
        f32x4 v[4]; float s = 0.f;
#pragma unroll
        for (int j = 0; j < 4; ++j) { v[j] = xr[lane + 64 * j]; s += (v[j][0] + v[j][1]) + (v[j][2] + v[j][3]); }
#pragma unroll
        for (int o = 1; o < 64; o <<= 1) s += __shfl_xor(s, o);
        const float mean = s * (1.f / 1024.f); float q = 0.f;
#pragma unroll
        for (int j = 0; j < 4; ++j) { v[j] = v[j] - mean; q += (v[j][0] * v[j][0] + v[j][1] * v[j][1]) + (v[j][2] * v[j][2] + v[j][3] * v[j][3]); }
#pragma unroll
        for (int o = 1; o < 64; o <<= 1) q += __shfl_xor(q, o);
        const float rstd = rsqrtf(q * (1.f / 1024.f) + LN_EPS);
#pragma unroll
        for (int j = 0; j < 4; ++j) {
            const f32x4 gg = ((const f32x4*)g)[lane + 64 * j], bb = ((const f32x4*)bta)[lane + 64 * j];
            const f32x4 y = v[j] * rstd * gg + bb;
            xr[lane + 64 * j] = y;
            u32x2 o; o.x = pack2(y[0], y[1]); o.y = pack2(y[2], y[3]);
            ((u32x2*)(xb + (size_t)row * 1024))[lane + 64 * j] = o;
        }
    }
}

DI void gmlp_item(const Params& p, int item, char* lds) {
    const int tid = get_tid(), lane = tid & 63, w = tid >> 6, wr = w >> 1, wc = w & 1, fr = lane & 15, fq = lane >> 4;
    const int g = item & 3, n = (item >> 2) & 15, b = item >> 6;
    const u16* H = (const u16*)(p.ws + O_H);
    u16* YM = (u16*)(p.ws + O_YM);
    u16* sW = (u16*)lds; u16* sV = sW + 128 * 136;
    const size_t row_base = (size_t)b * SEQ + n * 128;
    vsync();
    {
        const float* Wg = p.in[11] + (size_t)g * 128 * 128;
#pragma unroll 4
        for (int c = tid; c < 128 * 32; c += 256) {
            const int t = c >> 5, s4 = (c & 31) * 4;
            const f32x4 v = *(const f32x4*)(Wg + t * 128 + s4);
            u32x2 o; o.x = pack2(s4 + 0 <= t ? v[0] : 0.f, s4 + 1 <= t ? v[1] : 0.f); o.y = pack2(s4 + 2 <= t ? v[2] : 0.f, s4 + 3 <= t ? v[3] : 0.f);
            *(u32x2*)(sW + t * 136 + s4) = o;
        }
    }
    {
        const int r = tid >> 1, half = tid & 1;
        const u16* src = H + (row_base + r) * 3072 + 512 + g * 128 + half * 64;
        float x[64]; float s = 0.f;
#pragma unroll
        for (int j = 0; j < 8; ++j) {
            const u32x4 q = *(const u32x4*)(src + j * 8);
#pragma unroll
            for (int e = 0; e < 4; ++e) { x[j * 8 + 2 * e] = __uint_as_float(q[e] << 16); x[j * 8 + 2 * e + 1] = __uint_as_float(q[e] & 0xffff0000u); }
        }
#pragma unroll
        for (int j = 0; j < 64; ++j) s += x[j];
        s += __shfl_xor(s, 1);
        const float mean = s * (1.f / 128.f); float q2 = 0.f;
#pragma unroll
        for (int j = 0; j < 64; ++j) { x[j] -= mean; q2 += x[j] * x[j]; }
        q2 += __shfl_xor(q2, 1);
        const float rstd = rsqrtf(q2 * (1.f / 128.f) + LN_EPS);
        const float* lg = p.in[13] + g * 128 + half * 64; const float* lb = p.in[14] + g * 128 + half * 64;
#pragma unroll
        for (int j = 0; j < 64; ++j) sV[(half * 64 + j) * 136 + r] = f2bf(x[j] * rstd * lg[j] + lb[j]);
    }
    vsync();
    f32x4 acc[4][4];
#pragma unroll
    for (int i = 0; i < 4; ++i)
#pragma unroll
        for (int j = 0; j < 4; ++j) acc[i][j] = (f32x4){0.f, 0.f, 0.f, 0.f};
    const u16* cA = sW + (wr * 64 + fr) * 136 + fq * 8;
    const u16* cB = sV + (wc * 64 + fr) * 136 + fq * 8;
#pragma unroll
    for (int ks = 0; ks < 4; ++ks) {
        bf16x8 a[4], bb[4];
#pragma unroll
        for (int i = 0; i < 4; ++i) { a[i] = *(const bf16x8*)(cA + i * 16 * 136 + ks * 32); bb[i] = *(const bf16x8*)(cB + i * 16 * 136 + ks * 32); }
#pragma unroll
        for (int i = 0; i < 4; ++i)
#pragma unroll
            for (int j = 0; j < 4; ++j) acc[i][j] = mfma16(a[i], bb[j], acc[i][j]);
    }
    const float* bs = p.in[12] + g * 128;
#pragma unroll
    for (int mi = 0; mi < 4; ++mi)
#pragma unroll
        for (int i = 0; i < 4; ++i) {
            const int t = wr * 64 + mi * 16 + fq * 4 + i; const float bt = bs[t];
#pragma unroll
            for (int ni = 0; ni < 4; ++ni) {
                const int c = wc * 64 + ni * 16 + fr;
                const float u = bf2f(H[(row_base + t) * 3072 + g * 128 + c]);
                YM[(row_base + t) * 1024 + g * 128 + c] = f2bf(u * (acc[mi][ni][i] + bt));
            }
        }
}

template <int ROWS, int COLS, int LD>
DI void stage_tile(u16* s, const u16* g, int ld) {
    constexpr int CPR = COLS / 8, TOT = ROWS * CPR;
    const int tid = get_tid();
#pragma unroll
    for (int c0 = 0; c0 < TOT; c0 += 256) { const int c = c0 + tid, r = c / CPR, cc = (c % CPR) * 8; *(u32x4*)(s + r * LD + cc) = *(const u32x4*)(g + (size_t)r * ld + cc); }
}

DI void hgrn_prep_cum(const u16* src, int th, int ch, float* sTot, float (&cum)[32], float& total) {
    float run = 0.f;
#pragma unroll
    for (int j = 0; j < 32; ++j) { run += bf2f(src[(size_t)j * 3072 + 1536]); cum[j] = run; }
    sTot[th * 128 + ch] = run;
    vsync();
    const float t0 = sTot[ch], t1 = sTot[128 + ch], off = th ? t0 : 0.f;
    total = t0 + t1;
#pragma unroll
    for (int j = 0; j < 32; ++j) cum[j] += off;
}

DI void hgrnA_item(const Params& p, int item, char* lds) {
    const int tid = get_tid(), lane = tid & 63, w = tid >> 6, fr = lane & 15, fq = lane >> 4;
    const int n = item & 31, bh = item >> 5, h = bh & 3, b = bh >> 2;
    const u16* H = (const u16*)(p.ws + O_H);
    u16* YM = (u16*)(p.ws + O_YM);
    float* U = p.out + (size_t)item * 16384;
    float* DEC = (float*)(p.ws + O_KM + 512 * 1024) + (size_t)item * 128;
    u16* sQ = (u16*)lds;
    u16* sKd = sQ + 64 * 136;
    u16* sKt = sKd + 64 * 136;
    u16* sI = sKt + 128 * 72;
    float* sTot = (float*)(sI + 128 * 72);
    u16* sAt = sKd;
    const int ch = tid & 127, th = tid >> 7;
    const size_t row_base = (size_t)b * SEQ + n * 64;
    vsync();
    {
        const u16* src = H + (row_base + th * 32) * 3072 + h * 128 + ch;
        float cum[32]; float total;
        hgrn_prep_cum(src, th, ch, sTot, cum, total);
        if (th == 0) DEC[ch] = __expf(total);
        float prev = th ? sTot[ch] : 0.f;
#pragma unroll
        for (int j8 = 0; j8 < 4; ++j8) {
            unsigned kt[4], iv[4];
#pragma unroll
            for (int jj = 0; jj < 8; ++jj) {
                const int j = j8 * 8 + jj;
                const float c = cum[j], lf = c - prev; prev = c;
                const float q = bf2f(src[(size_t)j * 3072 + 1024]);
                const unsigned ivv = src[(size_t)j * 3072 + 2048];
                const float kc = 1.f - __expf(lf);
                sQ[(th * 32 + j) * 136 + ch] = f2bf(q * __expf(c));
                sKd[(th * 32 + j) * 136 + ch] = f2bf(kc * __expf(-c));
                const unsigned ktv = f2bf(kc * __expf(total - c));
                if (jj & 1) { kt[jj >> 1] |= ktv << 16; iv[jj >> 1] |= ivv << 16; } else { kt[jj >> 1] = ktv; iv[jj >> 1] = ivv; }
            }
            *(u32x4*)(sKt + ch * 72 + th * 32 + j8 * 8) = (u32x4){kt[0], kt[1], kt[2], kt[3]};
            *(u32x4*)(sI + ch * 72 + th * 32 + j8 * 8) = (u32x4){iv[0], iv[1], iv[2], iv[3]};
        }
    }
    vsync();
    f32x4 at[4];
#pragma unroll
    for (int nt = 0; nt < 4; ++nt) at[nt] = (f32x4){0.f, 0.f, 0.f, 0.f};
#pragma unroll
    for (int ks = 0; ks < 4; ++ks) {
        const bf16x8 a = *(const bf16x8*)(sQ + (16 * w + fr) * 136 + ks * 32 + fq * 8);
#pragma unroll
        for (int nt = 0; nt < 4; ++nt) { const bf16x8 bb = *(const bf16x8*)(sKd + (nt * 16 + fr) * 136 + ks * 32 + fq * 8); at[nt] = mfma16(a, bb, at[nt]); }
    }
    vsync();
#pragma unroll
    for (int nt = 0; nt < 4; ++nt)
#pragma unroll
        for (int i = 0; i < 4; ++i) { const int t = 16 * w + fq * 4 + i, s = nt * 16 + fr; sAt[t * 72 + s] = f2bf(s <= t ? at[nt][i] : 0.f); }
    vsync();
    {
        f32x4 oacc[4][2];
#pragma unroll
        for (int mt = 0; mt < 4; ++mt) { oacc[mt][0] = (f32x4){0.f, 0.f, 0.f, 0.f}; oacc[mt][1] = (f32x4){0.f, 0.f, 0.f, 0.f}; }
#pragma unroll
        for (int ks = 0; ks < 2; ++ks) {
            bf16x8 bb[2];
#pragma unroll
            for (int nt = 0; nt < 2; ++nt) bb[nt] = *(const bf16x8*)(sI + (32 * w + nt * 16 + fr) * 72 + ks * 32 + fq * 8);
#pragma unroll
            for (int mt = 0; mt < 4; ++mt) {
                const bf16x8 a = *(const bf16x8*)(sAt + (mt * 16 + fr) * 72 + ks * 32 + fq * 8);
                oacc[mt][0] = mfma16(a, bb[0], oacc[mt][0]); oacc[mt][1] = mfma16(a, bb[1], oacc[mt][1]);
            }
        }
#pragma unroll
        for (int mt = 0; mt < 4; ++mt)
#pragma unroll
            for (int nt = 0; nt < 2; ++nt)
#pragma unroll
                for (int i = 0; i < 4; ++i)
                    YM[(row_base + mt * 16 + fq * 4 + i) * 1024 + 512 + h * 128 + 32 * w + nt * 16 + fr] = f2bf(oacc[mt][nt][i]);
    }
    {
        f32x4 u[2][8];
#pragma unroll
        for (int mt = 0; mt < 2; ++mt)
#pragma unroll
            for (int nt = 0; nt < 8; ++nt) u[mt][nt] = (f32x4){0.f, 0.f, 0.f, 0.f};
#pragma unroll
        for (int ks = 0; ks < 2; ++ks) {
            bf16x8 a[2];
#pragma unroll
            for (int mt = 0; mt < 2; ++mt) a[mt] = *(const bf16x8*)(sI + (32 * w + mt * 16 + fr) * 72 + ks * 32 + fq * 8);
#pragma unroll
            for (int nt = 0; nt < 8; ++nt) {
                const bf16x8 bb = *(const bf16x8*)(sKt + (nt * 16 + fr) * 72 + ks * 32 + fq * 8);
                u[0][nt] = mfma16(a[0], bb, u[0][nt]); u[1][nt] = mfma16(a[1], bb, u[1][nt]);
            }
        }
#pragma unroll
        for (int mt = 0; mt < 2; ++mt)
#pragma unroll
            for (int nt = 0; nt < 8; ++nt)
#pragma unroll
                for (int i = 0; i < 4; ++i) U[(32 * w + mt * 16 + fq * 4 + i) * 128 + nt * 16 + fr] = u[mt][nt][i];
    }
}

DI void hgrn_scan(const Params& p) {
    const int tid = get_tid8();
    const float* U = p.out;
    const float* DEC = (const float*)(p.ws + O_KM + 512 * 1024);
    u16* ST = (u16*)(p.ws + O_XB);
    for (int idx = blockIdx.x * 512 + tid; idx < 32 * 4096; idx += gridDim.x * 512) {
        const int bh = idx >> 12, e4 = (idx & 4095) * 4, k = e4 & 127;
        f32x4 s = (f32x4){0.f, 0.f, 0.f, 0.f};
#pragma unroll 8
        for (int n = 0; n < 32; ++n) {
            const size_t item = (size_t)bh * 32 + n;
            const f32x4 u = *(const f32x4*)(U + item * 16384 + e4);
            const f32x4 d = *(const f32x4*)(DEC + item * 128 + k);
            u32x2 o; o.x = pack2(s[0], s[1]); o.y = pack2(s[2], s[3]);
            *(u32x2*)(ST + item * 16384 + e4) = o;
            s = d * s + u;
        }
    }
}

DI void hgrnC_item(const Params& p, int item, char* lds) {
    const int tid = get_tid(), lane = tid & 63, w = tid >> 6, fr = lane & 15, fq = lane >> 4;
    const int n = item & 31, bh = item >> 5, h = bh & 3, b = bh >> 2;
    const u16* H = (const u16*)(p.ws + O_H);
    u16* YM = (u16*)(p.ws + O_YM);
    const u16* ST = (const u16*)(p.ws + O_XB) + (size_t)item * 16384;
    u16* sQ = (u16*)lds;
    u16* sS = sQ + 64 * 136;
    float* sTot = (float*)(sS + 128 * 136);
    float* sSsq = sTot + 256;
    const float* gn = p.in[15] + h * 128;
    const int ch = tid & 127, th = tid >> 7;
    const size_t row_base = (size_t)b * SEQ + n * 64;
    vsync();
    stage_tile<128, 128, 136>(sS, ST, 128);
    {
        const u16* src = H + (row_base + th * 32) * 3072 + h * 128 + ch;
        float cum[32]; float total;
        hgrn_prep_cum(src, th, ch, sTot, cum, total);
#pragma unroll
        for (int j = 0; j < 32; ++j) sQ[(th * 32 + j) * 136 + ch] = f2bf(bf2f(src[(size_t)j * 3072 + 1024]) * __expf(cum[j]));
    }
    vsync();
    f32x4 oacc[4][2];
#pragma unroll
    for (int mt = 0; mt < 4; ++mt) { oacc[mt][0] = (f32x4){0.f, 0.f, 0.f, 0.f}; oacc[mt][1] = (f32x4){0.f, 0.f, 0.f, 0.f}; }
#pragma unroll
    for (int ks = 0; ks < 4; ++ks) {
        bf16x8 bb[2];
#pragma unroll
        for (int nt = 0; nt < 2; ++nt) bb[nt] = *(const bf16x8*)(sS + (32 * w + nt * 16 + fr) * 136 + ks * 32 + fq * 8);
#pragma unroll
        for (int mt = 0; mt < 4; ++mt) {
            const bf16x8 a = *(const bf16x8*)(sQ + (mt * 16 + fr) * 136 + ks * 32 + fq * 8);
            oacc[mt][0] = mfma16(a, bb[0], oacc[mt][0]); oacc[mt][1] = mfma16(a, bb[1], oacc[mt][1]);
        }
    }
#pragma unroll
    for (int mt = 0; mt < 4; ++mt)
#pragma unroll
        for (int i = 0; i < 4; ++i) {
#pragma unroll
            for (int nt = 0; nt < 2; ++nt) oacc[mt][nt][i] += bf2f(YM[(row_base + mt * 16 + fq * 4 + i) * 1024 + 512 + h * 128 + 32 * w + nt * 16 + fr]);
            float q = oacc[mt][0][i] * oacc[mt][0][i] + oacc[mt][1][i] * oacc[mt][1][i];
            q += __shfl_xor(q, 1); q += __shfl_xor(q, 2); q += __shfl_xor(q, 4); q += __shfl_xor(q, 8);
            if (fr == 0) sSsq[w * 64 + mt * 16 + fq * 4 + i] = q;
        }
    vsync();
#pragma unroll
    for (int mt = 0; mt < 4; ++mt)
#pragma unroll
        for (int i = 0; i < 4; ++i) {
            const int t = mt * 16 + fq * 4 + i;
            const float tot = (sSsq[t] + sSsq[64 + t]) + (sSsq[128 + t] + sSsq[192 + t]);
            const float r = rsqrtf(tot * (1.f / 128.f) + LN_EPS);
#pragma unroll
            for (int nt = 0; nt < 2; ++nt) {
                const int v = 32 * w + nt * 16 + fr;
                const float gate = bf2f(H[(row_base + t) * 3072 + 2560 + h * 128 + v]);
                YM[(row_base + t) * 1024 + 512 + h * 128 + v] = f2bf(oacc[mt][nt][i] * r * gn[v] * gate);
            }
        }
}

DI void chunk_load(u32x4 (&r)[4], const u16* g, int ld, bool vtype, int tid) {
#pragma unroll
    for (int i = 0; i < 4; ++i) { const int c = tid + i * 256; const int row = vtype ? (c >> 4) : (c >> 3), cc = vtype ? ((c & 15) * 8) : ((c & 7) * 8); r[i] = *(const u32x4*)(g + (size_t)row * ld + cc); }
}
DI void chunk_store(const u32x4 (&r)[4], u16* s, bool vtype, int tid) {
#pragma unroll
    for (int i = 0; i < 4; ++i) { const int c = tid + i * 256; const int row = vtype ? (c >> 4) : (c >> 3), cc = vtype ? ((c & 15) * 8) : ((c & 7) * 8); *(u32x4*)(s + row * (vtype ? 136 : 72) + cc) = r[i]; }
}
DI void attn_qk(f32x4 (&sacc)[8], const u16* sK, bf16x8 b0, bf16x8 b1, int fr, int fq) {
#pragma unroll
    for (int mt = 0; mt < 8; ++mt) {
        const u16* a = sK + (mt * 16 + fr) * 72 + fq * 8;
        sacc[mt] = mfma16(*(const bf16x8*)a, b0, sacc[mt]);
        sacc[mt] = mfma16(*(const bf16x8*)(a + 32), b1, sacc[mt]);
    }
}
template <int NO, int OFF>
DI void attn_pv(f32x4 (&oacc)[NO], const u16* sV, const bf16x8 (&pb)[4], int fr, int fq) {
#pragma unroll
    for (int s = 0; s < 4; ++s)
#pragma unroll
        for (int mt = 0; mt < 4; ++mt) {
            const u16* va = sV + (mt * 16 + fr) * 136 + 32 * s + fq * 4;
            oacc[OFF + mt] = mfma16(mk8(*(const u32x2*)va, *(const u32x2*)(va + 16)), pb[s], oacc[OFF + mt]);
        }
}
template <int NO>
DI void attn_softmax(f32x4 (&sacc)[8], f32x4 (&oacc)[NO], float& m, float& l, bf16x8 (&pb)[4]) {
    float mx = -1e30f;
#pragma unroll
    for (int mt = 0; mt < 8; ++mt) mx = fmaxf(fmaxf(mx, fmaxf(sacc[mt][0], sacc[mt][1])), fmaxf(sacc[mt][2], sacc[mt][3]));
    mx = fmaxf(mx, __shfl_xor(mx, 16)); mx = fmaxf(mx, __shfl_xor(mx, 32));
    const float mnew = fmaxf(m, mx), corr = __builtin_amdgcn_exp2f(m - mnew);
    l *= corr;
#pragma unroll
    for (int i = 0; i < NO; ++i) oacc[i] = oacc[i] * corr;
    float ps = 0.f;
#pragma unroll
    for (int mt = 0; mt < 8; ++mt)
#pragma unroll
        for (int i = 0; i < 4; ++i) { const float pe = __builtin_amdgcn_exp2f(sacc[mt][i] - mnew); ps += pe; sacc[mt][i] = pe; }
    l += ps; m = mnew;
#pragma unroll
    for (int s = 0; s < 4; ++s) pb[s] = pack8(sacc[2 * s], sacc[2 * s + 1]);
}

DI void cross_item(const Params& p, int l, int item, char* lds) {
    const int tid = get_tid(), lane = tid & 63, w = tid >> 6, fr = lane & 15, fq = lane >> 4;
    const int qt = item & 31, h = (item >> 5) & 3, b = item >> 7;
    const u16* Q = (const u16*)(p.ws + O_H);
    const u16* Kd = (const u16*)(p.ws + O_KVK + l * 4 * MB) + ((size_t)b * 256) * 1024 + h * 256;
    const u16* Vt = (const u16*)(p.ws + O_KVV + l * 4 * MB) + ((size_t)(b * 4 + h) * 256) * 256;
    u16* O = (u16*)(p.ws + O_YM);
    u16* sbuf = (u16*)lds;
    const size_t qrow = (size_t)b * SEQ + qt * 64 + w * 16 + fr;
    u16* sQ = sbuf + 2 * 9216 + w * (16 * 264);
    vsync();
#pragma unroll
    for (int i = 0; i < 8; ++i) *(u32x4*)(sQ + fr * 264 + i * 32 + fq * 8) = *(const u32x4*)(Q + qrow * 1024 + h * 256 + i * 32 + fq * 8);
    f32x4 oacc[16];
#pragma unroll
    for (int i = 0; i < 16; ++i) oacc[i] = (f32x4){0.f, 0.f, 0.f, 0.f};
    float m = -1e30f, lsum = 0.f;
    f32x4 sacc[8]; bf16x8 pb[4];
    u32x4 rg[4];
    chunk_load(rg, Kd, 1024, false, tid);
    chunk_store(rg, sbuf, false, tid);
    vsync();
    for (int kt = 0; kt < 2; ++kt) {
#pragma unroll
        for (int j = 0; j < 8; ++j) {
            if (j < 3) chunk_load(rg, Kd + (size_t)kt * 128 * 1024 + (j + 1) * 64, 1024, false, tid);
            else if (j < 7) chunk_load(rg, Vt + (size_t)(j - 3) * 64 * 256 + kt * 128, 256, true, tid);
            else if (kt == 0) chunk_load(rg, Kd + (size_t)128 * 1024, 1024, false, tid);
            const u16* sb = sbuf + (j & 1) * 9216;
            if (j < 4) {
                if (j == 0) {
#pragma unroll
                    for (int i = 0; i < 8; ++i) sacc[i] = (f32x4){0.f, 0.f, 0.f, 0.f};
                }
                attn_qk(sacc, sb, *(const bf16x8*)(sQ + fr * 264 + j * 64 + fq * 8), *(const bf16x8*)(sQ + fr * 264 + j * 64 + 32 + fq * 8), fr, fq);
                if (j == 3) attn_softmax<16>(sacc, oacc, m, lsum, pb);
            } else if (j == 4) attn_pv<16, 0>(oacc, sb, pb, fr, fq);
            else if (j == 5) attn_pv<16, 4>(oacc, sb, pb, fr, fq);
            else if (j == 6) attn_pv<16, 8>(oacc, sb, pb, fr, fq);
            else attn_pv<16, 12>(oacc, sb, pb, fr, fq);
            if (j < 7 || kt == 0) chunk_store(rg, sbuf + ((j + 1) & 1) * 9216, (j >= 3 && j < 7), tid);
            vsync();
            __builtin_amdgcn_sched_barrier(0);
        }
    }
    lsum += __shfl_xor(lsum, 16); lsum += __shfl_xor(lsum, 32);
    const float inv = 1.f / lsum;
#pragma unroll
    for (int i = 0; i < 16; ++i) {
        u32x2 o; o.x = pack2(oacc[i][0] * inv, oacc[i][1] * inv); o.y = pack2(oacc[i][2] * inv, oacc[i][3] * inv);
        *(u32x2*)(O + qrow * 1024 + h * 256 + i * 16 + fq * 4) = o;
    }
}

DI void moba_item(const Params& p, int item, char* lds) {
    const int tid = get_tid(), lane = tid & 63, w = tid >> 6, fr = lane & 15, fq = lane >> 4;
    const int qt = 31 - (item >> 7), bh = item & 127, h = bh & 15, b = bh >> 4;
    const u16* Q = (const u16*)(p.ws + O_H);
    const u16* Kd = (const u16*)(p.ws + O_H + 32 * MB) + ((size_t)b * SEQ) * 1024 + h * 64;
    const u16* Vt = (const u16*)(p.ws + O_H + 64 * MB) + ((size_t)(b * 16 + h) * 64) * 2048;
    const float* KM = (const float*)(p.ws + O_KM);
    u16* O = (u16*)(p.ws + O_YM);
    u16* sbuf = (u16*)lds;
    const int q0 = qt * 64, qblk = q0 >> 8, tq = q0 + w * 16 + fr;
    const size_t qrow = (size_t)b * SEQ + tq;
    bf16x8 bq[2];
#pragma unroll
    for (int i = 0; i < 2; ++i) bq[i] = *(const bf16x8*)(Q + qrow * 1024 + h * 64 + i * 32 + fq * 8);
    const int ktop = q0 >> 7, nchunk = 2 * (ktop + 1);
    u32x4 rg[4];
    chunk_load(rg, Kd + (size_t)ktop * 128 * 1024, 1024, false, tid);
    unsigned sel = 0;
    if (qblk > 0) {
        float aff[8];
#pragma unroll
        for (int j = 0; j < 8; ++j) aff[j] = 0.f;
        const u16* qp = Q + qrow * 1024 + h * 64;
        const float* km = KM + (size_t)bh * 8 * 64;
#pragma unroll
        for (int d8 = 0; d8 < 8; ++d8) {
            const u32x4 qv = *(const u32x4*)(qp + d8 * 8);
            float qf[8];
#pragma unroll
            for (int e = 0; e < 4; ++e) { qf[2 * e] = __uint_as_float(qv[e] << 16); qf[2 * e + 1] = __uint_as_float(qv[e] & 0xffff0000u); }
#pragma unroll
            for (int j = 0; j < 7; ++j)
                if (j < qblk) {
#pragma unroll
                    for (int e = 0; e < 8; ++e) aff[j] += qf[e] * km[j * 64 + d8 * 8 + e];
                }
        }
#pragma unroll
        for (int j = 0; j < 7; ++j) {
            int rank = 0;
#pragma unroll
            for (int j2 = 0; j2 < 7; ++j2) if (j2 < qblk && j2 != j && (aff[j2] > aff[j] || (aff[j2] == aff[j] && j2 < j))) ++rank;
            if (j < qblk && rank < 3) sel |= 1u << j;
        }
    }
    chunk_store(rg, sbuf, false, tid);
    vsync();
    f32x4 oacc[4];
#pragma unroll
    for (int i = 0; i < 4; ++i) oacc[i] = (f32x4){0.f, 0.f, 0.f, 0.f};
    float m = -1e30f, lsum = 0.f;
    const float sl2 = exp2f(-0.5f * (float)(h + 1)) * 1.4426950408889634f;
    f32x4 sacc[8]; bf16x8 pb[4];
    for (int c = 0; c < nchunk; ++c) {
        const int kt = ktop - (c >> 1);
        if (c + 1 < nchunk) {
            if (c & 1) chunk_load(rg, Kd + (size_t)(kt - 1) * 128 * 1024, 1024, false, tid);
            else chunk_load(rg, Vt + kt * 128, 2048, true, tid);
        }
        if ((c & 1) == 0) {
#pragma unroll
            for (int i = 0; i < 8; ++i) sacc[i] = (f32x4){0.f, 0.f, 0.f, 0.f};
            attn_qk(sacc, sbuf, bq[0], bq[1], fr, fq);
            const int key0 = kt * 128, jb = key0 >> 8, dqi = tq - key0 - fq * 4;
            float base = -sl2 * (float)dqi;
            if (jb < qblk && !((sel >> jb) & 1u)) base = -1e30f;
            if (c == 0) {
#pragma unroll
                for (int mt = 0; mt < 8; ++mt)
#pragma unroll
                    for (int i = 0; i < 4; ++i) { const int e = mt * 16 + i; const float sv = fmaf(sl2, (float)e, sacc[mt][i] + base); sacc[mt][i] = (e <= dqi) ? sv : -1e30f; }
            } else {
#pragma unroll
                for (int mt = 0; mt < 8; ++mt)
#pragma unroll
                    for (int i = 0; i < 4; ++i) sacc[mt][i] = fmaf(sl2, (float)(mt * 16 + i), sacc[mt][i] + base);
            }
            attn_softmax<4>(sacc, oacc, m, lsum, pb);
        } else attn_pv<4, 0>(oacc, sbuf + 9216, pb, fr, fq);
        if (c + 1 < nchunk) chunk_store(rg, sbuf + ((c + 1) & 1) * 9216, ((c + 1) & 1) != 0, tid);
        vsync();
    }
    lsum += __shfl_xor(lsum, 16); lsum += __shfl_xor(lsum, 32);
    const float inv = 1.f / lsum;
#pragma unroll
    for (int i = 0; i < 4; ++i) {
        u32x2 o; o.x = pack2(oacc[i][0] * inv, oacc[i][1] * inv); o.y = pack2(oacc[i][2] * inv, oacc[i][3] * inv);
        *(u32x2*)(O + qrow * 1024 + h * 64 + i * 16 + fq * 4) = o;
    }
}

DI void kmean_item(const Params& p, int item, char* lds) {
    const int tid = get_tid(), d = tid & 63, part = tid >> 6;
    const int j = item & 7, bh = item >> 3, h = bh & 15, b = bh >> 4;
    const u16* Kd = (const u16*)(p.ws + O_H + 32 * MB) + ((size_t)b * SEQ + j * 256 + part * 64) * 1024 + h * 64 + d;
    float* red = (float*)lds;
    float s = 0.f;
#pragma unroll 8
    for (int i = 0; i < 64; ++i) s += bf2f(Kd[(size_t)i * 1024]);
    vsync();
    red[part * 64 + d] = s;
    vsync();
    if (part == 0) ((float*)(p.ws + O_KM))[(size_t)item * 64 + d] = ((red[d] + red[64 + d]) + (red[128 + d] + red[192 + d])) * (1.f / 256.f);
}

DI void vtrans_item(const u16* src, int src_ld, u16* dst, int dst_ld, char* lds) {
    const int tid = get_tid();
    u16* sT = (u16*)lds;
    vsync();
#pragma unroll
    for (int i = 0; i < 2; ++i) {
        const int c = tid + i * 256, r = c >> 3, cc = (c & 7) * 8;
        const u32x4 v = *(const u32x4*)(src + (size_t)r * src_ld + cc);
#pragma unroll
        for (int e = 0; e < 4; ++e) { sT[(cc + 2 * e) * 72 + r] = (u16)(v[e] & 0xffffu); sT[(cc + 2 * e + 1) * 72 + r] = (u16)(v[e] >> 16); }
    }
    vsync();
#pragma unroll
    for (int i = 0; i < 2; ++i) {
        const int c = tid + i * 256, r = c >> 3, cc = (c & 7) * 8;
        *(u32x4*)(dst + (size_t)r * dst_ld + cc) = *(const u32x4*)(sT + r * 72 + cc);
    }
}
DI void vtrans_cross(const Params& p, int item, char* lds) {
    const int dt = item & 3, mt = (item >> 2) & 3, h = (item >> 4) & 3, b = (item >> 6) & 7, l = item >> 9;
    const u16* src = (const u16*)(p.ws + O_VRAW + l * 4 * MB) + ((size_t)b * 256 + mt * 64) * 1024 + h * 256 + dt * 64;
    u16* dst = (u16*)(p.ws + O_KVV + l * 4 * MB) + ((size_t)((b * 4 + h) * 256 + dt * 64)) * 256 + mt * 64;
    vtrans_item(src, 1024, dst, 256, lds);
}
DI void vtrans_moba(const Params& p, int item, char* lds) {
    const int tt = item & 31, h = (item >> 5) & 15, b = item >> 9;
    const u16* src = (const u16*)(p.ws + O_YM) + ((size_t)b * SEQ + tt * 64) * 1024 + h * 64;
    u16* dst = (u16*)(p.ws + O_H + 64 * MB) + ((size_t)((b * 16 + h) * 64)) * 2048 + tt * 64;
    vtrans_item(src, 1024, dst, 2048, lds);
}

__global__ void __launch_bounds__(512, 2) mega(Params p) {
    extern __shared__ __attribute__((aligned(16))) char lds[];
    cg::grid_group grid = cg::this_grid();
    char* ws = p.ws;
    volatile LAS unsigned* xst = (volatile LAS unsigned*)(lds + 2 * LDS_MAIN);
    if (threadIdx.x == 0) { for (int i = 0; i < 8; ++i) xst[i] = 0u; }
    __syncthreads();
    const XcdBarrier xb = xcd_barrier_post((unsigned*)(ws + O_BAR), xst);
#ifdef TMASK
    unsigned long long t_prev = __builtin_amdgcn_s_memrealtime(), t_acc = 0;
#endif
    for (int pi = p.ph0; pi < p.ph1; ++pi) {
        int t_ = threadIdx.x; asm volatile("" : "+v"(t_));
        ws = p.ws; asm volatile("" : "+s"(ws));
        u16* XB = (u16*)(ws + O_XB); u16* Hb = (u16*)(ws + O_H); u16* YM = (u16*)(ws + O_YM);
        const int vb = t_ >> 8, vbid = blockIdx.x * 2 + vb, nvb = gridDim.x * 2;
        char* vlds = lds + vb * LDS_MAIN;
        const int ph = pi < 3 ? pi : (pi < 5 ? 21 + pi : pi - 2);
        const int l = (ph >= 12 && ph < 24) ? 1 : 0;
        const bool is_gemm = (ph == 1 || ph == 3 || ph == 5 || ph == 7 || ph == 9 || ph == 10 || ph == 12 || ph == 15 || ph == 17 || ph == 19 || ph == 21 || ph == 22);
        if (is_gemm) {
            for (int sub = 0; sub < (ph == 1 ? 2 : 1); ++sub) {
                const u16* A = XB; const u16* Bt = nullptr; int M = NT, N = 1024, K = 1024, et = 1;
                EpiSplit es; es.d0 = Hb; es.d1 = Hb; es.d2 = Hb; es.d3 = Hb; es.scale0 = 1.f;
                EpiZ ez; ez.res = p.out; ez.out = p.out;
                if (ph == 1 && sub == 0) { Bt = (const u16*)(ws + O_WT_EVIN); N = 3072; et = 0; }
                else if (ph == 1) { A = (const u16*)(ws + O_MEMB); Bt = (const u16*)(ws + O_WT_WKV); M = 2048; N = 4096;
                    es.d0 = (u16*)(ws + O_KVK); es.d1 = (u16*)(ws + O_VRAW); es.d2 = (u16*)(ws + O_KVK + 4 * MB); es.d3 = (u16*)(ws + O_VRAW + 4 * MB); }
                else if (ph == 5 || ph == 17) { Bt = (const u16*)(ws + O_WT_WQ + l * 2 * MB); es.scale0 = 0.0625f * 1.4426950408889634f; }
                else if (ph == 12) { Bt = (const u16*)(ws + O_WT_QKV); N = 3072; es.d1 = (u16*)(ws + O_H + 32 * MB); es.d2 = YM; es.d3 = YM; es.scale0 = 0.125f * 1.4426950408889634f; }
                else if (ph == 9 || ph == 21) { Bt = (const u16*)(ws + O_WT_FIN + l * 11 * MB); N = 2 * DFF; et = 3; }
                else {
                    et = 2;
                    const bool ffn = (ph == 10 || ph == 22);
                    A = ffn ? Hb : YM; K = ffn ? DFF : 1024;
                    if (ph == 3) ez.res = p.in[0];
                    const size_t wo = (ph == 3) ? O_WT_EVOUT : (ph == 15) ? O_WT_ODOUT : ffn ? (O_WT_FOUT + l * (11 * MB / 2)) : (O_WT_WO + l * 2 * MB);
                    Bt = (const u16*)(ws + wo);
                }
                if (et == 0) { EpiH0 e0; e0.H = Hb; e0.lbl = p.in[16]; run_gemm(lds, A, Bt, M, N, K, e0); }
                else if (et == 1) run_gemm(lds, A, Bt, M, N, K, es);
                else if (et == 2) run_gemm(lds, A, Bt, M, N, K, ez);
                else { EpiFFN e; e.Hd = Hb; run_gemm(lds, A, Bt, M, N, K, e); }
            }
        } else
        switch (ph) {
        case 0: phase_prep(p, vlds, vbid, nvb); break;
        case 2: { for (int it = vbid; it < 1024 + 512 + 1024; it += nvb) { if (it < 1024) hgrnA_item(p, it, vlds); else if (it < 1536) gmlp_item(p, it - 1024, vlds); else vtrans_cross(p, it - 1536, vlds); } } break;
        case 24: hgrn_scan(p); break;
        case 25: { for (int it = vbid; it < 1024; it += nvb) hgrnC_item(p, it, vlds); } break;
        case 4: case 8: case 11: case 16: case 20: case 23: {
            const int k = (ph == 4 || ph == 16) ? 0 : ((ph == 8 || ph == 20) ? 1 : 2);
            phase_ln(p.in[2] + (l * 3 + k) * 1024, p.in[3] + (l * 3 + k) * 1024, p.out, XB);
        } break;
        case 6: case 18: { for (int it = vbid; it < 1024; it += nvb) if (EN(6)) cross_item(p, l, it, vlds); } break;
        case 13: { for (int it = vbid; it < 1024 + 4096; it += nvb) { if (it < 1024) kmean_item(p, it, vlds); else vtrans_moba(p, it - 1024, vlds); } } break;
        case 14: { for (int it = vbid; it < 4096; it += nvb) if (EN(14)) moba_item(p, it, vlds); } break;
        default: break;
        }
        if (pi + 1 < p.ph1) { if (p.use_cg) grid.sync(); else xcd_barrier(xb); }
#ifdef TMASK
        { const unsigned long long now = __builtin_amdgcn_s_memrealtime(); if ((TMASK >> ph) & 1u) t_acc += now - t_prev; t_prev = now; }
        if (pi + 1 == p.ph1 && blockIdx.x == 0) { const unsigned long long t0 = __builtin_amdgcn_s_memrealtime(); while (__builtin_amdgcn_s_memrealtime() - t0 < t_acc) __builtin_amdgcn_s_sleep(8); }
#endif
    }
}

extern "C" void kernel_launch(void* const* d_in, const int* in_sizes, int n_in, void* d_out, int out_size, void* d_ws, size_t ws_size, hipStream_t stream) {
    static int grid = 0;
    if (grid == 0) {
        if (n_in != 19 || ws_size < WS_END) { fprintf(stderr, "kernel_launch: unexpected n_in %d / ws %zu (need %zu)\n", n_in, ws_size, (size_t)WS_END); grid = -1; return; }
        int dev = 0, cus = 0, per_cu = 0;
        (void)hipGetDevice(&dev);
        (void)hipDeviceGetAttribute(&cus, hipDeviceAttributeMultiprocessorCount, dev);
        if (hipFuncSetAttribute((const void*)mega, hipFuncAttributeMaxDynamicSharedMemorySize, LDS_BYTES) != hipSuccess) { fprintf(stderr, "hipFuncSetAttribute failed\n"); grid = -1; return; }
        if (hipOccupancyMaxActiveBlocksPerMultiprocessor(&per_cu, (const void*)mega, 512, LDS_BYTES) != hipSuccess || per_cu < 1) { fprintf(stderr, "occupancy query failed\n"); grid = -1; return; }
        grid = cus;
        grid -= grid % 8;
        fprintf(stderr, "kernel_launch: grid %d (cus %d per_cu %d)\n", grid, cus, per_cu);
    }
    if (grid < 0) return;
    Params p{};
    for (int i = 0; i < 19; ++i) p.in[i] = (const float*)d_in[i];
    p.out = (float*)d_out; p.ws = (char*)d_ws;
    p.ph0 = 0; p.ph1 = NPHASE; p.use_cg = 0;
    if (hipMemsetAsync((char*)d_ws + O_BAR, 0, XCD_BAR_WORDS * 4, stream) != hipSuccess) { fprintf(stderr, "memset failed\n"); return; }
    void* args[] = {&p};
    hipError_t e = hipLaunchCooperativeKernel((void*)mega, dim3(grid), dim3(512), args, LDS_BYTES, stream);
    if (e != hipSuccess) fprintf(stderr, "cooperative launch failed: %s (grid %d)\n", hipGetErrorString(e), grid);
}
```
